# Optimizing an MI355X kernel written in HIP

```python
import math
import jax, jax.numpy as jnp
from jax import lax
import numpy as np

D_MODEL = 1024
BATCH = 4
SEQ = 8192
DEPTH = 1

HEAD_DIM = 128
HEADS_PER_GROUP = 4
ATTN_PATTERNS = ((128, 1), (512, 4), (2048, 16))
N_ATTN_HEADS = HEADS_PER_GROUP * len(ATTN_PATTERNS)
ATTN_QKV_WIDTH = N_ATTN_HEADS * HEAD_DIM
ATTN_OUT_WIDTH = HEADS_PER_GROUP * HEAD_DIM
FOURIER_GROUPS = 4
FOURIER_GROUP_DIM = 128
FOURIER_WIDTH = FOURIER_GROUPS * FOURIER_GROUP_DIM
N_BRANCHES = 2
IN_WIDTH = 3 * ATTN_QKV_WIDTH + FOURIER_WIDTH + N_BRANCHES * D_MODEL
D_FF = 2752
NUM_BUCKETS = 32
MAX_EXACT = 8
MAX_DISTANCE = 1024
NEG_INF = -1e30
LN_EPS = 1e-5
ALPHA = (2 * DEPTH) ** 0.25
BETA = (8 * DEPTH) ** -0.25

kernel_name = "hybrid_dilated_attn_fnet_macaron_encoder"


def layer_norm(x, g, b):
    xf = x.astype(jnp.float32)
    mu = jnp.mean(xf, axis=-1, keepdims=True)
    var = jnp.mean(jnp.square(xf - mu), axis=-1, keepdims=True)
    y = (xf - mu) * lax.rsqrt(var + LN_EPS) * g.astype(jnp.float32) + b.astype(jnp.float32)
    return y.astype(x.dtype)


def swiglu(x, w_gate, w_up, w_down):
    return (jax.nn.silu(x @ w_gate) * (x @ w_up)) @ w_down


def t5_bucket(rel):
    half = NUM_BUCKETS // 2
    ret = (rel > 0).astype(jnp.int32) * half
    n = jnp.abs(rel)
    nf = jnp.maximum(n, 1).astype(jnp.float32)
    large = MAX_EXACT + (jnp.log(nf / MAX_EXACT) / math.log(MAX_DISTANCE / MAX_EXACT)
                         * (half - MAX_EXACT)).astype(jnp.int32)
    large = jnp.minimum(large, half - 1)
    return ret + jnp.where(n < MAX_EXACT, n, large)


def dilated_window_attention(q, k, v, rel_bias_g, window, dilation):
    B, S, H, E = q.shape
    half = window // (2 * dilation)
    blk = half
    L = S // dilation
    nb = -(-L // blk)
    Lp = nb * blk
    scale = E ** -0.5

    def to_sub(t):
        return t.reshape(B, L, dilation, H, E).transpose(0, 2, 3, 1, 4)

    qs, ks, vs = to_sub(q), to_sub(k), to_sub(v)
    qb = jnp.pad(qs, ((0, 0),) * 3 + ((0, Lp - L), (0, 0))).reshape(B, dilation, H, nb, blk, E)

    def windows(t):
        tp = jnp.pad(t, ((0, 0),) * 3 + ((blk, Lp - L + blk), (0, 0)))
        tp = tp.reshape(B, dilation, H, nb + 2, blk, E)
        return jnp.concatenate([tp[:, :, :, :-2], tp[:, :, :, 1:-1], tp[:, :, :, 2:]], axis=4)

    kw, vw = windows(ks), windows(vs)

    a_idx = jnp.arange(blk, dtype=jnp.int32)[:, None]
    b_idx = jnp.arange(3 * blk, dtype=jnp.int32)[None, :]
    off = b_idx - blk - a_idx
    band = jnp.abs(off) <= half
    key_pos = jnp.arange(nb, dtype=jnp.int32)[:, None] * blk - blk + jnp.arange(3 * blk, dtype=jnp.int32)[None, :]
    valid = (key_pos >= 0) & (key_pos < L)
    mask = band[None] & valid[:, None, :]
    bias = rel_bias_g[t5_bucket(off * dilation)]
    bias = jnp.moveaxis(bias, -1, 0).astype(jnp.float32)
    logit_add = jnp.where(mask[None], bias[:, None], NEG_INF)

    s = jnp.einsum('bdhnqe,bdhnke->bdhnqk', qb, kw).astype(jnp.float32) * scale + logit_add
    mx = jnp.max(s, axis=-1, keepdims=True)
    p = jnp.exp(s - mx)
    den = jnp.sum(p, axis=-1)
    o = jnp.einsum('bdhnqk,bdhnke->bdhnqe', p, vw.astype(jnp.float32)) / den[..., None]
    lse = mx[..., 0] + jnp.log(den)

    o = o.reshape(B, dilation, H, Lp, E)[:, :, :, :L].transpose(0, 3, 1, 2, 4).reshape(B, S, H, E)
    lse = lse.reshape(B, dilation, H, Lp)[:, :, :, :L].transpose(0, 3, 1, 2).reshape(B, S, H)
    return o, lse


def hybrid_mixer(x, w_in, b_in, rel_bias, w_proj_attn, w_proj_fourier, w_out):
    B, S, _ = x.shape
    h = x @ w_in + b_in
    A = ATTN_QKV_WIDTH
    q = h[..., 0:A].reshape(B, S, N_ATTN_HEADS, HEAD_DIM)
    k = h[..., A:2 * A].reshape(B, S, N_ATTN_HEADS, HEAD_DIM)
    v = h[..., 2 * A:3 * A].reshape(B, S, N_ATTN_HEADS, HEAD_DIM)
    u = h[..., 3 * A:3 * A + FOURIER_WIDTH]
    gates = jax.nn.sigmoid(h[..., 3 * A + FOURIER_WIDTH:])

    outs, lses = [], []
    for g, (window, dilation) in enumerate(ATTN_PATTERNS):
        sl = slice(g * HEADS_PER_GROUP, (g + 1) * HEADS_PER_GROUP)
        o, l = dilated_window_attention(q[:, :, sl], k[:, :, sl], v[:, :, sl],
                                        rel_bias[:, sl], window, dilation)
        outs.append(o)
        lses.append(l)
    w_mix = jax.nn.softmax(jnp.stack(lses, axis=0), axis=0)
    attn = jnp.sum(w_mix[..., None] * jnp.stack(outs, axis=0), axis=0)
    attn = attn.reshape(B, S, ATTN_OUT_WIDTH).astype(x.dtype)

    uf = u.astype(jnp.float32).reshape(B, S, FOURIER_GROUPS, FOURIER_GROUP_DIM)
    four = jnp.real(jnp.fft.fft2(uf, axes=(1, 3), norm='ortho'))
    four = four.reshape(B, S, FOURIER_WIDTH).astype(x.dtype)

    g_attn = gates[..., :D_MODEL]
    g_four = gates[..., D_MODEL:]
    merged = g_attn * (attn @ w_proj_attn) + g_four * (four @ w_proj_fourier)
    return merged @ w_out


def setup_inputs(seed: int = 0) -> dict:
    key = jax.random.key(seed)
    ks = jax.random.split(key, 20)

    def nrm(k, shape, scale):
        return jax.random.normal(k, shape, jnp.float32) * scale

    D, F = D_MODEL, D_FF
    return {
        "x": nrm(ks[0], (BATCH, SEQ, D), 1.0),
        "ln1_g": 1.0 + nrm(ks[1], (DEPTH, D), 0.02),
        "ln1_b": nrm(ks[2], (DEPTH, D), 0.02),
        "ffn1_w_gate": nrm(ks[3], (DEPTH, D, F), D ** -0.5),
        "ffn1_w_up": nrm(ks[4], (DEPTH, D, F), D ** -0.5),
        "ffn1_w_down": nrm(ks[5], (DEPTH, F, D), F ** -0.5 * BETA),
        "w_in": nrm(ks[6], (DEPTH, D, IN_WIDTH), D ** -0.5),
        "b_in": nrm(ks[7], (DEPTH, IN_WIDTH), 0.02),
        "rel_bias": nrm(ks[8], (NUM_BUCKETS, N_ATTN_HEADS), 0.5),
        "w_proj_attn": nrm(ks[9], (DEPTH, ATTN_OUT_WIDTH, D), ATTN_OUT_WIDTH ** -0.5),
        "w_proj_fourier": nrm(ks[10], (DEPTH, FOURIER_WIDTH, D), FOURIER_WIDTH ** -0.5),
        "w_out": nrm(ks[11], (DEPTH, D, D), D ** -0.5 * BETA),
        "ln2_g": 1.0 + nrm(ks[12], (DEPTH, D), 0.02),
        "ln2_b": nrm(ks[13], (DEPTH, D), 0.02),
        "ffn2_w_gate": nrm(ks[14], (DEPTH, D, F), D ** -0.5),
        "ffn2_w_up": nrm(ks[15], (DEPTH, D, F), D ** -0.5),
        "ffn2_w_down": nrm(ks[16], (DEPTH, F, D), F ** -0.5 * BETA),
        "ln3_g": 1.0 + nrm(ks[17], (DEPTH, D), 0.02),
        "ln3_b": nrm(ks[18], (DEPTH, D), 0.02),
    }


def reference(x, ln1_g, ln1_b, ffn1_w_gate, ffn1_w_up, ffn1_w_down, w_in, b_in, rel_bias,
              w_proj_attn, w_proj_fourier, w_out, ln2_g, ln2_b, ffn2_w_gate, ffn2_w_up,
              ffn2_w_down, ln3_g, ln3_b):
    h = x
    for l in range(DEPTH):
        h = layer_norm(ALPHA * h + 0.5 * swiglu(h, ffn1_w_gate[l], ffn1_w_up[l], ffn1_w_down[l]),
                       ln1_g[l], ln1_b[l])
        h = layer_norm(ALPHA * h + hybrid_mixer(h, w_in[l], b_in[l], rel_bias, w_proj_attn[l],
                                                w_proj_fourier[l], w_out[l]),
                       ln2_g[l], ln2_b[l])
        h = layer_norm(ALPHA * h + 0.5 * swiglu(h, ffn2_w_gate[l], ffn2_w_up[l], ffn2_w_down[l]),
                       ln3_g[l], ln3_b[l])
    return h
```

```cpp
#include <hip/hip_runtime.h>
#include <cstdio>
#include <cstdint>

#ifndef MK_N_LAUNCHES
#define MK_N_LAUNCHES 14
#endif

namespace pg8 {
#define PG8_LAS __attribute__((address_space(3)))
typedef unsigned short bf16_t;
typedef short bf16x8 __attribute__((ext_vector_type(8)));
typedef float f32x4 __attribute__((ext_vector_type(4)));
typedef float f32x2 __attribute__((ext_vector_type(2)));
typedef unsigned u32x4 __attribute__((ext_vector_type(4)));
typedef unsigned u32x2 __attribute__((ext_vector_type(2)));
constexpr int BM = 256, BK = 64, HALF = 128, HTB = HALF * BK * 2, STAGE_BYTES = 8 * HTB, NXCD = 8, WGM = 8;

__host__ __device__ __forceinline__ int lds_byte(int r, int c) { const int st = (r >> 4) * 2 + (c >> 5), rr = r & 15, cc = c & 31, ob = rr * 64 + cc * 2; return st * 1024 + (ob ^ (((ob >> 9) & 1) << 5)); }
__host__ __device__ __forceinline__ void stage_rc(int b, int& R, int& C) { const int st = b / 1024, sb = b % 1024, swz = sb ^ (((sb >> 9) & 1) << 5); R = (st >> 1) * 16 + swz / 64; C = (st & 1) * 32 + (swz % 64) / 2; }
__host__ __device__ __forceinline__ int perm32(int rho) { const int n = rho >> 4, i = rho & 15; return 8 * (i >> 2) + 4 * n + (i & 3); }

struct Unit { int pm, pn, kind; };

__device__ __forceinline__ void tile_of(int L, int nM, int nN, int& pm, int& pn) {
    const int nwg = nM * nN; int wgid = L;
    { const int q = nwg / NXCD, r = nwg % NXCD, xcd = wgid % NXCD, off = wgid / NXCD; wgid = (xcd < r ? xcd * (q + 1) : r * (q + 1) + (xcd - r) * q) + off; }
    const int nig = WGM * nN, gid = wgid / nig, fm = gid * WGM, gsz = (nM - fm) < WGM ? (nM - fm) : WGM;
    pm = fm + ((wgid % nig) % gsz); pn = (wgid % nig) / gsz;
}

__device__ __forceinline__ unsigned cvt_pk_bf16(float lo, float hi) { unsigned r; asm volatile("v_cvt_pk_bf16_f32 %0, %1, %2" : "=v"(r) : "v"(lo), "v"(hi)); return r; }
__device__ __forceinline__ float bf_lo(unsigned w) { return __uint_as_float(w << 16); }
__device__ __forceinline__ float bf_hi(unsigned w) { return __uint_as_float(w & 0xffff0000u); }

template <class Epi, class Sched>
__device__ __forceinline__ void gemm_phase(PG8_LAS unsigned char* lds, const int K, const Sched& S, const Epi& E) {
    const int tid = threadIdx.x, wid = __builtin_amdgcn_readfirstlane(tid >> 6), lane = tid & 63, wr = wid >> 2, wc = wid & 3, fr = lane & 15, fq = lane >> 4;
    const int nt = K / BK;
    const int lda = S.lda(), ldb = S.ldb();
    unsigned voffA[2], cvB[2], nvB[2];
    Unit cur, nxt; int ui = 0;
    if (!S.next(0, cur)) return;
#define PG8_VB(dst, u) do { _Pragma("unroll") for (int _i = 0; _i < 2; ++_i) { int R_, C_; stage_rc(tid * 16 + _i * 8192, R_, C_); const int Rb_ = Epi::PERM ? ((R_ & ~31) + perm32(R_ & 31)) : R_; \
        if constexpr (Sched::GATHER) dst[_i] = (unsigned)(S.btok(u, Rb_) * ldb + C_) * 2u; else dst[_i] = (unsigned)(Rb_ * ldb + C_) * 2u; } } while (0)
#pragma unroll
    for (int i = 0; i < 2; ++i) { int R, C; stage_rc(tid * 16 + i * 8192, R, C); voffA[i] = (unsigned)(R * lda + C) * 2u; }
    PG8_VB(cvB, cur);
    const size_t kstep = (size_t)(BK * 2);
    const size_t hstepA = (size_t)HALF * lda * 2;
    size_t chB, nhB;
    if constexpr (Sched::GATHER) chB = S.bhalf(cur); else chB = (size_t)HALF * ldb * 2;
    nhB = chB; nvB[0] = cvB[0]; nvB[1] = cvB[1];
    const unsigned ldsw = (unsigned)wid * 1024u;
    const int aoff = lds_byte(wr * 64 + fr, fq * 8), boff = lds_byte(wc * 32 + fr, fq * 8);
#define PG8_SA(b, h) (((b) * 2 + (h)) * HTB)
#define PG8_SB(b, h) ((4 + (b) * 2 + (h)) * HTB)
#define PG8_STAGE(bufoff, gbase, v0, v1) do { \
        __builtin_amdgcn_global_load_lds((const unsigned*)((const char*)(gbase) + (v0)), (PG8_LAS unsigned*)(lds + (bufoff) + ldsw), 16, 0, 0); \
        __builtin_amdgcn_global_load_lds((const unsigned*)((const char*)(gbase) + (v1)), (PG8_LAS unsigned*)(lds + (bufoff) + ldsw + 8192), 16, 0, 0); } while (0)
#define PG8_STA(bufoff, gbase) PG8_STAGE(bufoff, gbase, voffA[0], voffA[1])
#define PG8_LDA(dst, b, h) do { _Pragma("unroll") for (int m = 0; m < 4; ++m) _Pragma("unroll") for (int k = 0; k < 2; ++k) dst[m][k] = *(const PG8_LAS bf16x8*)(lds + PG8_SA(b, h) + aoff + m * 2048 + k * 1024); } while (0)
#define PG8_LDB(dst, b, h) do { _Pragma("unroll") for (int n = 0; n < 2; ++n) _Pragma("unroll") for (int k = 0; k < 2; ++k) dst[n][k] = *(const PG8_LAS bf16x8*)(lds + PG8_SB(b, h) + boff + n * 2048 + k * 1024); } while (0)
#define PG8_MMA(ai, bj, At, Bt) do { __builtin_amdgcn_s_setprio(1); _Pragma("unroll") for (int m = 0; m < 4; ++m) _Pragma("unroll") for (int n = 0; n < 2; ++n) _Pragma("unroll") for (int k = 0; k < 2; ++k) \
        acc[ai][bj][m][n] = __builtin_amdgcn_mfma_f32_16x16x32_bf16(Bt[n][k], At[m][k], acc[ai][bj][m][n], 0, 0, 0); __builtin_amdgcn_s_setprio(0); } while (0)
#define PG8_WAIT_V(n) asm volatile("s_waitcnt vmcnt(" #n ")" ::: "memory")
#define PG8_WAIT_L(n) asm volatile("s_waitcnt lgkmcnt(" #n ")" ::: "memory")
#define PG8_BAR __builtin_amdgcn_s_barrier()
#define PG8_SCHED __builtin_amdgcn_sched_barrier(0)
    f32x4 acc[2][2][4][2];
#pragma unroll
    for (int a = 0; a < 2; ++a)
#pragma unroll
        for (int b = 0; b < 2; ++b)
#pragma unroll
            for (int m = 0; m < 4; ++m)
#pragma unroll
                for (int n = 0; n < 2; ++n) acc[a][b][m][n] = (f32x4){0.f, 0.f, 0.f, 0.f};
    bf16x8 At[4][2], B0[2][2], B1[2][2];
    const char* cA = S.abase(cur); const char* cB = S.bbase(cur);
    PG8_STAGE(PG8_SB(0, 0), cB, cvB[0], cvB[1]); PG8_STAGE(PG8_SB(0, 1), cB + chB, cvB[0], cvB[1]); PG8_STA(PG8_SA(0, 0), cA); PG8_STA(PG8_SA(0, 1), cA + hstepA);
    if (wr == 1) PG8_BAR;
    PG8_WAIT_V(2); PG8_BAR;
    PG8_STAGE(PG8_SB(1, 0), cB + kstep, cvB[0], cvB[1]); PG8_STA(PG8_SA(1, 0), cA + kstep); PG8_STAGE(PG8_SB(1, 1), cB + chB + kstep, cvB[0], cvB[1]);
    PG8_WAIT_V(6); PG8_BAR;
    for (;;) {
        const bool has_next = S.next(ui + 1, nxt);
        const char* nA = has_next ? S.abase(nxt) : cA; const char* nB = has_next ? S.bbase(nxt) : cB;
        if constexpr (Sched::GATHER) { if (has_next) { PG8_VB(nvB, nxt); nhB = S.bhalf(nxt); } else { nvB[0] = cvB[0]; nvB[1] = cvB[1]; nhB = chB; } }
        for (int t = 0; t < nt; t += 2) {
            const bool last = (t == nt - 2);
            const char* a1 = cA + (size_t)(t + 1) * kstep;
            const char* a2 = last ? nA : cA + (size_t)(t + 2) * kstep; const char* b2 = last ? nB : cB + (size_t)(t + 2) * kstep;
            const char* a3 = a2 + kstep; const char* b3 = b2 + kstep;
            unsigned v20, v21; size_t h2;
            if constexpr (Sched::GATHER) { v20 = last ? nvB[0] : cvB[0]; v21 = last ? nvB[1] : cvB[1]; h2 = last ? nhB : chB; } else { v20 = cvB[0]; v21 = cvB[1]; h2 = chB; }
            PG8_LDB(B0, 0, 0); PG8_LDB(B1, 0, 1); PG8_SCHED; PG8_LDA(At, 0, 0); PG8_STA(PG8_SA(1, 1), a1 + hstepA);
            PG8_WAIT_V(8); PG8_WAIT_L(0); PG8_BAR; PG8_MMA(0, 0, At, B0); PG8_MMA(0, 1, At, B1); PG8_BAR; PG8_SCHED;
            PG8_LDA(At, 0, 1); PG8_STAGE(PG8_SB(0, 0), b2, v20, v21); PG8_STAGE(PG8_SB(0, 1), b2 + h2, v20, v21); PG8_STA(PG8_SA(0, 0), a2);
            PG8_WAIT_V(8); PG8_WAIT_L(0); PG8_BAR; PG8_MMA(1, 0, At, B0); PG8_MMA(1, 1, At, B1); PG8_BAR; PG8_SCHED;
            PG8_LDB(B0, 1, 0); PG8_LDB(B1, 1, 1); PG8_SCHED; PG8_LDA(At, 1, 0); PG8_STA(PG8_SA(0, 1), a2 + hstepA);
            PG8_WAIT_V(8); PG8_WAIT_L(0); PG8_BAR; PG8_MMA(0, 0, At, B0); PG8_MMA(0, 1, At, B1); PG8_BAR; PG8_SCHED;
            PG8_LDA(At, 1, 1); PG8_STAGE(PG8_SB(1, 0), b3, v20, v21); PG8_STAGE(PG8_SB(1, 1), b3 + h2, v20, v21); PG8_STA(PG8_SA(1, 0), a3);
            PG8_WAIT_V(8); PG8_WAIT_L(0); PG8_BAR; PG8_MMA(1, 0, At, B0); PG8_MMA(1, 1, At, B1); PG8_BAR; PG8_SCHED;
        }
        if (wr == 0) PG8_BAR;
        E(acc, cur, wr, wc, fr, fq);
        if (!has_next) break;
#pragma unroll
        for (int a = 0; a < 2; ++a)
#pragma unroll
            for (int b = 0; b < 2; ++b)
#pragma unroll
                for (int m = 0; m < 4; ++m)
#pragma unroll
                    for (int n = 0; n < 2; ++n) acc[a][b][m][n] = (f32x4){0.f, 0.f, 0.f, 0.f};
        cur = nxt; cA = nA; cB = nB; ++ui;
        if constexpr (Sched::GATHER) { cvB[0] = nvB[0]; cvB[1] = nvB[1]; chB = nhB; }
        if (wr == 1) PG8_BAR;
    }
    PG8_WAIT_V(0);
    PG8_BAR;
#undef PG8_VB
#undef PG8_SA
#undef PG8_SB
#undef PG8_STAGE
#undef PG8_STA
#undef PG8_LDA
#undef PG8_LDB
#undef PG8_MMA
#undef PG8_WAIT_V
#undef PG8_WAIT_L
#undef PG8_BAR
#undef PG8_SCHED
}
}

constexpr int NWAVES = 8;
constexpr int N_LAUNCHES = MK_N_LAUNCHES;
constexpr int N_PHASES = 14;
constexpr int BATCH = 4, SEQ = 8192, T = BATCH * SEQ, D = 1024, FF = 2752, FFP = 2816, NUP = 2 * FFP;
constexpr int NH = 12, HD = 128, AQ = NH * HD;
constexpr int FW = 512;
constexpr int NIN = 2 * AQ + 2 * D;
constexpr int NSW = AQ + 2 * FW;
constexpr float LN_EPS = 1e-5f;
constexpr float ALPHA = 1.18920711500272f;
constexpr float QSCALE = 0.08838834764831845f;

constexpr size_t MiB = 1u << 20;
constexpr size_t WS_CTL = 0, CTL_ZERO_BYTES = 1 * MiB;
constexpr size_t WS_W1A = 1 * MiB, WS_W1D = 12 * MiB, WS_W2A = 18 * MiB, WS_W2D = 29 * MiB, WS_WIN = 35 * MiB, WS_WSW = 45 * MiB, WS_WPA = 50 * MiB, WS_WPF = 51 * MiB, WS_WOUT = 52 * MiB;
constexpr size_t WS_TAB = 54 * MiB;
constexpr size_t TAB_BIASN = 0, TAB_BIASW = 32768, TAB_TBL = 65536, TAB_COS = 81920, TAB_SIN = 81920 + 32768, TAB_LSE = 1 * MiB;
constexpr size_t WS_XB = 58 * MiB;
constexpr size_t WS_BIG = 122 * MiB;
constexpr size_t WS_ACT = WS_BIG;
constexpr size_t WS_QB = WS_BIG, WS_KB = WS_BIG + 96 * MiB, WS_VT = WS_BIG + 192 * MiB;
constexpr size_t WS_ATT = WS_KB, WS_FOUR = WS_KB + 32 * MiB, WS_MRG = WS_KB + 64 * MiB, WS_YP = WS_KB + 128 * MiB;
constexpr size_t WS_Z1 = 410 * MiB, WS_END = 474 * MiB;
static_assert(WS_YP + 64 * MiB <= WS_Z1 && WS_MRG + 64 * MiB <= WS_YP && WS_ACT + (size_t)T * FFP * 2 <= WS_Z1, "d_ws map");
constexpr int CW_BAR = 4096;

constexpr int RING_OFF = 0, RING_BYTES = 131072;
constexpr int LDSCTL_OFF = RING_BYTES, MISC_OFF = LDSCTL_OFF + 320, LTAB_OFF = RING_BYTES + 1024;
constexpr int LDS_BYTES = 147456;

#define GAS __attribute__((address_space(1)))
#define LAS __attribute__((address_space(3)))
typedef unsigned short bf16;
typedef unsigned v4u __attribute__((ext_vector_type(4)));
typedef unsigned v2u __attribute__((ext_vector_type(2)));
typedef float f32x4 __attribute__((ext_vector_type(4)));
#define RLX_AGENT __ATOMIC_RELAXED, __HIP_MEMORY_SCOPE_AGENT
#define LDS_WAIT() asm volatile("s_waitcnt lgkmcnt(0)" ::: "memory")
#define VM_WAIT() asm volatile("s_waitcnt vmcnt(0)" ::: "memory")
__device__ __forceinline__ unsigned f2bf(float f) { unsigned u = __builtin_bit_cast(unsigned, f); return (u + 0x7fffu + ((u >> 16) & 1u)) >> 16; }
__device__ __forceinline__ unsigned pk2(float lo, float hi) { return f2bf(lo) | (f2bf(hi) << 16); }
__device__ __forceinline__ float bf2f(unsigned short h) { return __uint_as_float(((unsigned)h) << 16); }

#define XB_TMO      128
#define XB_XCNT(j)  (256  + 64 * (j))
#define XB_XSUB(j)  (1280 + 64 * (j))
#define XB_XGEN(j)  (2304 + 64 * (j))
#define XB_TOP      3328
#define XB_TOPGEN   3392
#define XCD_BAR_WORDS 3456
#define XB_SPIN_CAP (1u << 18)
__device__ __forceinline__ unsigned xb_ld(unsigned* p)              { return __hip_atomic_load(p, __ATOMIC_RELAXED, __HIP_MEMORY_SCOPE_AGENT); }
__device__ __forceinline__ unsigned xb_add(unsigned* p, unsigned v) { return __hip_atomic_fetch_add(p, v, __ATOMIC_RELAXED, __HIP_MEMORY_SCOPE_AGENT); }
__device__ __forceinline__ unsigned xb_xcc_id() { return (unsigned)__builtin_amdgcn_s_getreg((3 << 11) | 20) & 0xFu; }
#define XB_SPIN(cond, bar) do { unsigned _sp = 0; while (cond) { __builtin_amdgcn_s_sleep(1); \
    if ((++_sp & 255u) == 0u) { if (xb_ld(&(bar)[XB_TMO])) break; if (_sp > XB_SPIN_CAP) { atomicAdd(&(bar)[XB_TMO], 1u); break; } } } } while (0)
struct XcdBarrier { unsigned* bar; unsigned x; volatile LAS unsigned* st; };
__device__ __forceinline__ XcdBarrier xcd_barrier_post(unsigned* bar, volatile LAS unsigned* st) {
    XcdBarrier b; b.bar = bar; b.x = xb_xcc_id(); b.st = st;
    if (threadIdx.x == 0) (void)xb_add(&bar[XB_XCNT(b.x)], 1u);
    return b;
}
__device__ __forceinline__ void xcd_barrier_complete(unsigned* bar, unsigned x, unsigned& nloc, unsigned& nx) {
    const unsigned G = gridDim.x * gridDim.y * gridDim.z;
    unsigned sum, cnt, mine, sp = 0u;
    for (;;) {
        sum = 0u; cnt = 0u; mine = 0u;
#pragma unroll
        for (unsigned j = 0; j < 16; ++j) { const unsigned c = xb_ld(&bar[XB_XCNT(j)]); sum += c; cnt += (c > 0u) ? 1u : 0u; mine = (j == x) ? c : mine; }
        if (sum == G) break;
        __builtin_amdgcn_s_sleep(1);
        if ((++sp & 255u) == 0u) { if (xb_ld(&bar[XB_TMO])) break; if (sp > XB_SPIN_CAP) { atomicAdd(&bar[XB_TMO], 1u); break; } }
    }
    nloc = mine > 0u ? mine : 1u; nx = cnt > 0u ? cnt : 1u;
}
__device__ __forceinline__ void xcd_barrier(const XcdBarrier& b) {
    asm volatile("s_waitcnt vmcnt(0)" ::: "memory");
    __syncthreads();
    if (threadIdx.x == 0) {
        unsigned* bar = b.bar;
        __builtin_amdgcn_s_waitcnt(0);
        unsigned nloc = b.st[0], nx = b.st[1];
        if (nloc == 0u) { xcd_barrier_complete(bar, b.x, nloc, nx); b.st[0] = nloc; b.st[1] = nx; }
        const unsigned old = xb_add(&bar[XB_XSUB(b.x)], 1u);
        const unsigned gen = old / nloc;
        if (old + 1u == (gen + 1u) * nloc) {
            __builtin_amdgcn_fence(__ATOMIC_RELEASE, "agent");
            asm volatile("s_waitcnt vmcnt(0)" ::: "memory");
            const unsigned og = xb_add(&bar[XB_TOP], 1u);
            const unsigned tg = og / nx;
            if (og + 1u == (tg + 1u) * nx) xb_add(&bar[XB_TOPGEN], 1u);
            else XB_SPIN(xb_ld(&bar[XB_TOPGEN]) == tg, bar);
            __builtin_amdgcn_fence(__ATOMIC_ACQUIRE, "agent");
            xb_add(&bar[XB_XGEN(b.x)], 1u);
            asm volatile("s_waitcnt vmcnt(0)" ::: "memory");
        } else {
            XB_SPIN(xb_ld(&bar[XB_XGEN(b.x)]) == gen, bar);
            __builtin_amdgcn_fence(__ATOMIC_ACQUIRE, "agent");
            asm volatile("s_waitcnt vmcnt(0)" ::: "memory");
        }
    }
    __syncthreads();
}

struct SchedStd {
    static constexpr bool GATHER = false;
    const bf16* A; const bf16* Bt; int lda_, ldb_, nM, nN, G, c;
    __device__ __forceinline__ int lda() const { return lda_; }
    __device__ __forceinline__ int ldb() const { return ldb_; }
    __device__ __forceinline__ bool next(int i, pg8::Unit& u) const { const long L = (long)i * G + c; if (L >= (long)nM * nN) return false; pg8::tile_of((int)L, nM, nN, u.pm, u.pn); u.kind = 0; return true; }
    __device__ __forceinline__ const char* abase(const pg8::Unit& u) const { return (const char*)A + (size_t)u.pm * 256 * lda_ * 2; }
    __device__ __forceinline__ const char* bbase(const pg8::Unit& u) const { return (const char*)Bt + (size_t)u.pn * 256 * ldb_ * 2; }
    __device__ __forceinline__ int btok(const pg8::Unit&, int j) const { return j; }
    __device__ __forceinline__ size_t bhalf(const pg8::Unit&) const { return (size_t)128 * ldb_ * 2; }
};
struct SchedProj {
    static constexpr bool GATHER = false;
    const bf16* ATT; const bf16* WPA; int G, c;
    __device__ __forceinline__ int lda() const { return FW; }
    __device__ __forceinline__ int ldb() const { return FW; }
    __device__ __forceinline__ bool next(int i, pg8::Unit& u) const { const long L = (long)(i >> 1) * G + c; if (L >= (long)(T / 256) * (D / 256)) return false; pg8::tile_of((int)L, T / 256, D / 256, u.pm, u.pn); u.kind = i & 1; return true; }
    __device__ __forceinline__ const char* abase(const pg8::Unit& u) const { return (const char*)ATT + ((size_t)u.kind * T * FW + (size_t)u.pm * 256 * FW) * 2; }
    __device__ __forceinline__ const char* bbase(const pg8::Unit& u) const { return (const char*)WPA + ((size_t)u.kind * D * FW + (size_t)u.pn * 256 * FW) * 2; }
    __device__ __forceinline__ int btok(const pg8::Unit&, int j) const { return j; }
    __device__ __forceinline__ size_t bhalf(const pg8::Unit&) const { return (size_t)128 * FW * 2; }
};
__device__ __forceinline__ int swap23(int j) { return (j & ~12) | ((j & 4) << 1) | ((j & 8) >> 1); }
struct SchedSw {
    static constexpr bool GATHER = true;
    const bf16* WSW; const bf16* H1; int G, c;
    __device__ __forceinline__ int lda() const { return D; }
    __device__ __forceinline__ int ldb() const { return D; }
    __device__ __forceinline__ bool next(int i, pg8::Unit& u) const { const long L = (long)i * G + c; if (L >= (long)(NSW / 256) * (T / 256)) return false; pg8::tile_of((int)L, NSW / 256, T / 256, u.pm, u.pn); u.kind = 0; return true; }
    __device__ __forceinline__ const char* abase(const pg8::Unit& u) const { return (const char*)WSW + (size_t)u.pm * 256 * D * 2; }
    __device__ __forceinline__ const char* bbase(const pg8::Unit& u) const {
        const int b = u.pn >> 5, nb0 = (u.pn & 31) * 256; int tok0;
        if (u.pm < 6) { const int sh = 2 * (u.pm >> 1), L = SEQ >> sh, r = nb0 / L, mp0 = nb0 & (L - 1); tok0 = b * SEQ + (mp0 << sh) + r; }
        else tok0 = b * SEQ + (u.pn & 31) * 4;
        return (const char*)H1 + (size_t)tok0 * D * 2;
    }
    __device__ __forceinline__ int btok(const pg8::Unit& u, int j) const { return (u.pm < 6) ? (swap23(j) << (2 * (u.pm >> 1))) : (128 * (j & 63) + (j >> 6)); }
    __device__ __forceinline__ size_t bhalf(const pg8::Unit& u) const { return (u.pm < 6) ? ((size_t)(128 << (2 * (u.pm >> 1))) * D * 2) : ((size_t)2 * D * 2); }
};

using pg8::f32x2;
__device__ __forceinline__ float sigmoidf_(float v) { return __builtin_amdgcn_rcpf(1.0f + __builtin_amdgcn_exp2f(-1.4426950408889634f * v)); }
struct EpiSwiGLU {
    static constexpr bool PERM = true;
    bf16* O;
    __device__ __forceinline__ void operator()(const f32x4 (&acc)[2][2][4][2], const pg8::Unit& u, int wr, int wc, int fr, int fq) const {
        const int row0 = u.pm * 256 + wr * 64 + fr, col0 = u.pn * 128 + wc * 32 + 8 * fq;
#pragma unroll
        for (int ai = 0; ai < 2; ++ai)
#pragma unroll
            for (int m = 0; m < 4; ++m) {
                float o[8];
#pragma unroll
                for (int n = 0; n < 2; ++n)
#pragma unroll
                    for (int j = 0; j < 4; ++j) { const float g = acc[ai][0][m][n][j], up = acc[ai][1][m][n][j]; o[4 * n + j] = g * sigmoidf_(g) * up; }
                v4u w; w.x = pg8::cvt_pk_bf16(o[0], o[1]); w.y = pg8::cvt_pk_bf16(o[2], o[3]); w.z = pg8::cvt_pk_bf16(o[4], o[5]); w.w = pg8::cvt_pk_bf16(o[6], o[7]);
                *(v4u*)(O + (size_t)(row0 + ai * 128 + m * 16) * FFP + col0) = w; }
    }
};
struct EpiInproj {
    static constexpr bool PERM = true;
    bf16* QB; bf16* KB; bf16* GATES; const float* bias;
    __device__ __forceinline__ void operator()(const f32x4 (&acc)[2][2][4][2], const pg8::Unit& u, int wr, int wc, int fr, int fq) const {
        const int row0 = u.pm * 256 + wr * 64 + fr, cw = wc * 32 + 8 * fq;
        bf16* base; int ldc, mode;
        if (u.pn < 6) { base = QB + u.pn * 256; ldc = AQ; mode = 0; } else if (u.pn < 12) { base = KB + (u.pn - 6) * 256; ldc = AQ; mode = 1; } else { base = GATES + (u.pn - 12) * 256; ldc = 2 * D; mode = 2; }
        f32x4 bv[2][2];
#pragma unroll
        for (int bj = 0; bj < 2; ++bj)
#pragma unroll
            for (int n = 0; n < 2; ++n) bv[bj][n] = *(const f32x4*)(bias + u.pn * 256 + bj * 128 + cw + 4 * n);
#pragma unroll
        for (int ai = 0; ai < 2; ++ai)
#pragma unroll
            for (int m = 0; m < 4; ++m) { bf16* rowp = base + (size_t)(row0 + ai * 128 + m * 16) * ldc + cw;
#pragma unroll
                for (int bj = 0; bj < 2; ++bj) { f32x4 v0 = acc[ai][bj][m][0] + bv[bj][0], v1 = acc[ai][bj][m][1] + bv[bj][1];
                    if (mode == 0) { v0 = v0 * QSCALE; v1 = v1 * QSCALE; }
                    if (mode == 2) {
#pragma unroll
                        for (int j = 0; j < 4; ++j) { v0[j] = sigmoidf_(v0[j]); v1[j] = sigmoidf_(v1[j]); } }
                    v4u w; w.x = pg8::cvt_pk_bf16(v0[0], v0[1]); w.y = pg8::cvt_pk_bf16(v0[2], v0[3]); w.z = pg8::cvt_pk_bf16(v1[0], v1[1]); w.w = pg8::cvt_pk_bf16(v1[2], v1[3]);
                    *(v4u*)(rowp + bj * 128) = w; } }
    }
};
struct EpiSw {
    static constexpr bool PERM = true;
    bf16* VT; bf16* Z1; const float* bias;
    __device__ __forceinline__ void operator()(const f32x4 (&acc)[2][2][4][2], const pg8::Unit& u, int wr, int wc, int fr, int fq) const {
        const int r0 = u.pm * 256 + wr * 64 + fr, n0 = u.pn * 256 + wc * 32 + 8 * fq;
#pragma unroll
        for (int ai = 0; ai < 2; ++ai)
#pragma unroll
            for (int m = 0; m < 4; ++m) { const int R = r0 + ai * 128 + m * 16; const float bs = bias[R];
#pragma unroll
                for (int bj = 0; bj < 2; ++bj) { const int n = n0 + bj * 128; const f32x4 v0 = acc[ai][bj][m][0] + bs, v1 = acc[ai][bj][m][1] + bs;
                    v4u w; w.x = pg8::cvt_pk_bf16(v0[0], v0[1]); w.y = pg8::cvt_pk_bf16(v0[2], v0[3]); w.z = pg8::cvt_pk_bf16(v1[0], v1[1]); w.w = pg8::cvt_pk_bf16(v1[2], v1[3]);
                    bf16* p;
                    if (u.pm < 6) p = VT + ((size_t)((n >> 13) * AQ + R) * SEQ + (n & (SEQ - 1)));
                    else { const int zr = R - AQ, ri = zr >> 9, ch = zr & 511, b = n >> 13, s2 = (n >> 6) & 127, s1 = n & 63; p = Z1 + ((((size_t)(ch * 4 + b) * 128 + s2) * 2 + ri) * 64 + s1); }
                    *(v4u*)p = w; } }
    }
};
struct EpiDown {
    static constexpr bool PERM = false;
    const float* res; float* out;
    __device__ __forceinline__ void operator()(const f32x4 (&acc)[2][2][4][2], const pg8::Unit& u, int wr, int wc, int fr, int fq) const {
        const int row0 = u.pm * 256 + wr * 64 + fr, col0 = u.pn * 256 + wc * 32 + 4 * fq;
#pragma unroll
        for (int ai = 0; ai < 2; ++ai)
#pragma unroll
            for (int m = 0; m < 4; ++m) { const size_t off = (size_t)(row0 + ai * 128 + m * 16) * D + col0;
#pragma unroll
                for (int bj = 0; bj < 2; ++bj)
#pragma unroll
                    for (int n = 0; n < 2; ++n) { const f32x4 r = *(const f32x4*)(res + off + bj * 128 + n * 16); *(f32x4*)(out + off + bj * 128 + n * 16) = r * ALPHA + acc[ai][bj][m][n] * 0.5f; } }
    }
};
struct EpiWout {
    static constexpr bool PERM = false;
    const bf16* res; float* out;
    __device__ __forceinline__ void operator()(const f32x4 (&acc)[2][2][4][2], const pg8::Unit& u, int wr, int wc, int fr, int fq) const {
        const int row0 = u.pm * 256 + wr * 64 + fr, col0 = u.pn * 256 + wc * 32 + 4 * fq;
#pragma unroll
        for (int ai = 0; ai < 2; ++ai)
#pragma unroll
            for (int m = 0; m < 4; ++m) { const size_t off = (size_t)(row0 + ai * 128 + m * 16) * D + col0;
#pragma unroll
                for (int bj = 0; bj < 2; ++bj)
#pragma unroll
                    for (int n = 0; n < 2; ++n) { const v2u rw = *(const v2u*)(res + off + bj * 128 + n * 16);
                        const f32x4 r = (f32x4){pg8::bf_lo(rw.x), pg8::bf_hi(rw.x), pg8::bf_lo(rw.y), pg8::bf_hi(rw.y)};
                        *(f32x4*)(out + off + bj * 128 + n * 16) = r * ALPHA + acc[ai][bj][m][n]; } }
    }
};
struct EpiProj {
    static constexpr bool PERM = true;
    const bf16* GATES; bf16* MRG;
    __device__ __forceinline__ void operator()(const f32x4 (&acc)[2][2][4][2], const pg8::Unit& u, int wr, int wc, int fr, int fq) const {
        const int row0 = u.pm * 256 + wr * 64 + fr, col0 = u.pn * 256 + wc * 32 + 8 * fq;
#pragma unroll
        for (int ai = 0; ai < 2; ++ai)
#pragma unroll
            for (int m = 0; m < 4; ++m) { const int row = row0 + ai * 128 + m * 16;
#pragma unroll
                for (int bj = 0; bj < 2; ++bj) { const int col = col0 + bj * 128;
                    const v4u gw = *(const v4u*)(GATES + (size_t)row * (2 * D) + u.kind * D + col);
                    float o[8]; const f32x4 a0 = acc[ai][bj][m][0], a1 = acc[ai][bj][m][1];
                    o[0] = pg8::bf_lo(gw.x) * a0[0]; o[1] = pg8::bf_hi(gw.x) * a0[1]; o[2] = pg8::bf_lo(gw.y) * a0[2]; o[3] = pg8::bf_hi(gw.y) * a0[3];
                    o[4] = pg8::bf_lo(gw.z) * a1[0]; o[5] = pg8::bf_hi(gw.z) * a1[1]; o[6] = pg8::bf_lo(gw.w) * a1[2]; o[7] = pg8::bf_hi(gw.w) * a1[3];
                    bf16* p = MRG + (size_t)row * D + col;
                    if (u.kind == 1) {
                        const unsigned long long q0 = __hip_atomic_load((const unsigned long long*)p, RLX_AGENT), q1 = __hip_atomic_load((const unsigned long long*)p + 1, RLX_AGENT);
                        const unsigned w0 = (unsigned)q0, w1 = (unsigned)(q0 >> 32), w2 = (unsigned)q1, w3 = (unsigned)(q1 >> 32);
                        o[0] += pg8::bf_lo(w0); o[1] += pg8::bf_hi(w0); o[2] += pg8::bf_lo(w1); o[3] += pg8::bf_hi(w1); o[4] += pg8::bf_lo(w2); o[5] += pg8::bf_hi(w2); o[6] += pg8::bf_lo(w3); o[7] += pg8::bf_hi(w3); }
                    v4u w; w.x = pg8::cvt_pk_bf16(o[0], o[1]); w.y = pg8::cvt_pk_bf16(o[2], o[3]); w.z = pg8::cvt_pk_bf16(o[4], o[5]); w.w = pg8::cvt_pk_bf16(o[6], o[7]);
                    *(v4u*)p = w; } }
    }
};

struct Ctx { LAS unsigned char* lds; int tid, lane, wave, G, gw, NGW; };
__device__ __forceinline__ float wave_sum(float v) {
#pragma unroll
    for (int o = 1; o < 64; o <<= 1) v += __shfl_xor(v, o);
    return v;
}
template <class RowMap>
__device__ __forceinline__ void tr_item(const float* W, int ldw, int k0, int n0, bf16* WT, int ldt, const RowMap& rm, LAS float* scr, int lane) {
#pragma unroll 8
    for (int i = 0; i < 32; ++i) { const int kk = 2 * i + (lane >> 5); scr[kk * 33 + (lane & 31)] = W[(size_t)(k0 + kk) * ldw + n0 + (lane & 31)]; }
    LDS_WAIT(); asm volatile("" ::: "memory");
    const int c = lane & 7;
#pragma unroll
    for (int j = 0; j < 4; ++j) { const int n = (lane >> 3) + 8 * j; const LAS float* s = scr + (8 * c) * 33 + n;
        v4u o; o.x = pk2(s[0 * 33], s[1 * 33]); o.y = pk2(s[2 * 33], s[3 * 33]); o.z = pk2(s[4 * 33], s[5 * 33]); o.w = pk2(s[6 * 33], s[7 * 33]);
        *(GAS v4u*)(WT + (size_t)rm(n0 + n) * ldt + k0 + 8 * c) = o; }
    LDS_WAIT(); asm volatile("" ::: "memory");
}
template <class RowMap>
__device__ __forceinline__ void tr_matrix(const Ctx& C, const float* W, int ldw, int K, int ncol0, int ncols, bf16* WT, int ldt, const RowMap& rm) {
    LAS float* scr = (LAS float*)(C.lds + RING_OFF + C.wave * 16384);
    const int nblk = ncols / 32, nitems = (K / 64) * nblk;
    for (int it = C.gw; it < nitems; it += C.NGW) { const int kb = it / nblk, nb = it % nblk; tr_item(W, ldw, 64 * kb, ncol0 + 32 * nb, WT, ldt, rm, scr, C.lane); }
}
struct RmOff { int off; __device__ __forceinline__ int operator()(int n) const { return n + off; } };
struct RmGU { int up; __device__ __forceinline__ int operator()(int n) const { return (n >> 7) * 256 + (n & 127) + up; } };

struct Inputs { const float *x, *ln1g, *ln1b, *w1g, *w1u, *w1d, *win, *bin, *relb, *wpa, *wpf, *wout, *ln2g, *ln2b, *w2g, *w2u, *w2d, *ln3g, *ln3b; };

__device__ __forceinline__ int t5_bucket(int rel) {
    const int ret = rel > 0 ? 16 : 0; const int n = rel < 0 ? -rel : rel;
    const float nf = (float)(n > 1 ? n : 1);
    int large = 8 + (int)(logf(nf / 8.0f) / 4.852030263919617f * 8.0f);
    large = large < 15 ? large : 15;
    return ret + (n < 8 ? n : large);
}

__device__ __forceinline__ void p0_prologue(const Ctx& C, const Inputs& I, unsigned char* ws) {
    bf16* W1A = (bf16*)(ws + WS_W1A); bf16* W1D = (bf16*)(ws + WS_W1D); bf16* W2A = (bf16*)(ws + WS_W2A); bf16* W2D = (bf16*)(ws + WS_W2D);
    bf16* WIN = (bf16*)(ws + WS_WIN); bf16* WSW = (bf16*)(ws + WS_WSW); bf16* WPA = (bf16*)(ws + WS_WPA); bf16* WPF = (bf16*)(ws + WS_WPF); bf16* WOUT = (bf16*)(ws + WS_WOUT);
    float* BIASN = (float*)(ws + WS_TAB + TAB_BIASN); float* BIASW = (float*)(ws + WS_TAB + TAB_BIASW); float* TBL = (float*)(ws + WS_TAB + TAB_TBL);
    float* COS = (float*)(ws + WS_TAB + TAB_COS); float* SIN = (float*)(ws + WS_TAB + TAB_SIN);
    bf16* XB = (bf16*)(ws + WS_XB);
    LAS float* lc = (LAS float*)(C.lds + LTAB_OFF); LAS float* ls = lc + 128;
    if (C.tid < 128) { lc[C.tid] = cospif((float)C.tid / 64.0f); ls[C.tid] = sinpif((float)C.tid / 64.0f); }
    __syncthreads();
    tr_matrix(C, I.w1g, FF, D, 0, FF, W1A, D, RmGU{0});   tr_matrix(C, I.w1u, FF, D, 0, FF, W1A, D, RmGU{128});
    tr_matrix(C, I.w2g, FF, D, 0, FF, W2A, D, RmGU{0});   tr_matrix(C, I.w2u, FF, D, 0, FF, W2A, D, RmGU{128});
    tr_matrix(C, I.w1d, D, FF, 0, D, W1D, FFP, RmOff{0}); tr_matrix(C, I.w2d, D, FF, 0, D, W2D, FFP, RmOff{0});
    tr_matrix(C, I.win, 7168, D, 0, AQ, WIN, D, RmOff{0});
    tr_matrix(C, I.win, 7168, D, AQ, AQ, WIN, D, RmOff{0});
    tr_matrix(C, I.win, 7168, D, 3 * AQ + FW, 2 * D, WIN, D, RmOff{2 * AQ - (3 * AQ + FW)});
    tr_matrix(C, I.win, 7168, D, 2 * AQ, AQ, WSW, D, RmOff{-2 * AQ});
    tr_matrix(C, I.wpa, D, FW, 0, D, WPA, FW, RmOff{0}); tr_matrix(C, I.wpf, D, FW, 0, D, WPF, FW, RmOff{0}); tr_matrix(C, I.wout, D, D, 0, D, WOUT, D, RmOff{0});
    const int gt = C.gw * 64 + C.lane, NGT = C.NGW * 64;
    for (int i = gt; i < 2 * 128 * (D / 8); i += NGT) { const int w = i / (128 * (D / 8)), r = (i / (D / 8)) % 128, c8 = i % (D / 8); const int row = 21 * 256 + 64 + (r & 63) + (r >> 6) * 128;
        *(v4u*)((w ? W2A : W1A) + (size_t)row * D + c8 * 8) = (v4u){0u, 0u, 0u, 0u}; }
    for (int i = gt; i < 2 * D * 8; i += NGT) { const int w = i / (D * 8), r = (i / 8) % D, c8 = i % 8; *(v4u*)((w ? W2D : W1D) + (size_t)r * FFP + FF + c8 * 8) = (v4u){0u, 0u, 0u, 0u}; }
    { LAS float* scr = (LAS float*)(C.lds + RING_OFF + C.wave * 16384);
      for (int it = C.gw; it < D * 4; it += C.NGW) { const int k = it >> 2, g = it & 3;
          const float* src = I.win + (size_t)k * 7168 + 3 * AQ + g * 128;
          scr[C.lane] = src[C.lane]; scr[C.lane + 64] = src[C.lane + 64];
          LDS_WAIT(); asm volatile("" ::: "memory");
          float ar0 = 0.f, ai0 = 0.f, ar1 = 0.f, ai1 = 0.f;
          for (int c = 0; c < 128; ++c) { const float w = scr[c]; const int i0 = (c * C.lane) & 127, i1 = (c * (C.lane + 64)) & 127;
              ar0 += w * lc[i0]; ai0 -= w * ls[i0]; ar1 += w * lc[i1]; ai1 -= w * ls[i1]; }
          WSW[(size_t)(AQ + g * 128 + C.lane) * D + k] = (bf16)f2bf(ar0);        WSW[(size_t)(AQ + g * 128 + C.lane + 64) * D + k] = (bf16)f2bf(ar1);
          WSW[(size_t)(AQ + 512 + g * 128 + C.lane) * D + k] = (bf16)f2bf(ai0);  WSW[(size_t)(AQ + 512 + g * 128 + C.lane + 64) * D + k] = (bf16)f2bf(ai1);
          LDS_WAIT(); asm volatile("" ::: "memory"); } }
    for (int i = gt; i < NIN; i += NGT) BIASN[i] = I.bin[i < 2 * AQ ? i : i + AQ + FW];
    for (int i = gt; i < NSW; i += NGT) {
        if (i < AQ) BIASW[i] = I.bin[2 * AQ + i];
        else { const int z = i - AQ, ri = z >> 9, g = (z >> 7) & 3, cp = z & 127; float a = 0.f;
            for (int c = 0; c < 128; ++c) { const int ix = (c * cp) & 127; a += I.bin[3 * AQ + g * 128 + c] * (ri ? -ls[ix] : lc[ix]); }
            BIASW[i] = a; } }
    for (int i = gt; i < NH * 129; i += NGT) { const int hd = i / 129, off = i % 129 - 64, dil = 1 << (2 * (hd >> 2)); TBL[i] = I.relb[t5_bucket(off * dil) * NH + hd]; }
    for (int i = gt; i < 8192; i += NGT) { COS[i] = cospif((float)i / 4096.0f); SIN[i] = sinpif((float)i / 4096.0f); }
    for (int m = C.gw; m < T; m += C.NGW) { const GAS f32x4* xr = (const GAS f32x4*)(I.x + (size_t)m * D) + C.lane; GAS unsigned long long* o8 = (GAS unsigned long long*)(XB + (size_t)m * D) + C.lane;
#pragma unroll
        for (int j = 0; j < 4; ++j) { const f32x4 v = xr[64 * j]; o8[64 * j] = (unsigned long long)pk2(v.x, v.y) | ((unsigned long long)pk2(v.z, v.w) << 32); } }
}

__device__ __forceinline__ void ln_pass(const Ctx& C, const float* v, float* outf, bf16* outb, const float* g, const float* b) {
    f32x4 gv[4], bv[4];
#pragma unroll
    for (int j = 0; j < 4; ++j) { gv[j] = *((const f32x4*)g + C.lane + 64 * j); bv[j] = *((const f32x4*)b + C.lane + 64 * j); }
    for (int m = C.gw; m < T; m += C.NGW) {
        const f32x4* xr = (const f32x4*)(v + (size_t)m * D) + C.lane;
        f32x4 x[4]; float s = 0.f;
#pragma unroll
        for (int j = 0; j < 4; ++j) { x[j] = xr[64 * j]; s += (x[j].x + x[j].y) + (x[j].z + x[j].w); }
        const float mean = wave_sum(s) * (1.f / D); float s2 = 0.f;
#pragma unroll
        for (int j = 0; j < 4; ++j) { x[j] = x[j] - mean; s2 += (x[j].x * x[j].x + x[j].y * x[j].y) + (x[j].z * x[j].z + x[j].w * x[j].w); }
        const float rstd = 1.f / sqrtf(wave_sum(s2) * (1.f / D) + LN_EPS);
#pragma unroll
        for (int j = 0; j < 4; ++j) { const f32x4 y = x[j] * rstd * gv[j] + bv[j];
            if (outf) *((f32x4*)(outf + (size_t)m * D) + C.lane + 64 * j) = y;
            if (outb) *((unsigned long long*)(outb + (size_t)m * D) + C.lane + 64 * j) = (unsigned long long)pk2(y.x, y.y) | ((unsigned long long)pk2(y.z, y.w) << 32); }
    }
}

__device__ __forceinline__ void attn_simple(const Ctx& C, bf16* QB, const bf16* KB, const bf16* VT, float* LSE, const float* TBL) {
    LAS float* slog = (LAS float*)(C.lds + RING_OFF + C.wave * 1024);
    for (int it = C.gw; it < T * NH; it += C.NGW) {
        const int tok = it / NH, hd = it % NH, g = hd >> 2, sh = 2 * g, L = SEQ >> sh, b = tok >> 13, s = tok & (SEQ - 1), r = s & ((1 << sh) - 1), m = s >> sh;
        const unsigned qw = *(const unsigned*)(QB + (size_t)tok * AQ + hd * HD + 2 * C.lane);
        const float q0 = pg8::bf_lo(qw), q1 = pg8::bf_hi(qw);
        float mx = -3.0e38f;
        for (int j = -64; j <= 64; ++j) { const int mk = m + j; float lg = -1e30f;
            if (mk >= 0 && mk < L) { const int kt = b * SEQ + (mk << sh) + r; const unsigned kw = *(const unsigned*)(KB + (size_t)kt * AQ + hd * HD + 2 * C.lane);
                lg = wave_sum(q0 * pg8::bf_lo(kw) + q1 * pg8::bf_hi(kw)) + TBL[hd * 129 + j + 64]; }
            if (C.lane == 0) slog[j + 64] = lg;
            mx = fmaxf(mx, lg); }
        LDS_WAIT(); asm volatile("" ::: "memory");
        float den = 0.f, o0 = 0.f, o1 = 0.f;
        const bf16* vrow = VT + ((size_t)(b * AQ + hd * HD + 2 * C.lane) * SEQ + r * L);
        for (int j = -64; j <= 64; ++j) { const int mk = m + j;
            if (mk >= 0 && mk < L) { const float p = __expf(slog[j + 64] - mx); den += p; const int pos = swap23(mk);
                o0 += p * bf2f(vrow[pos]); o1 += p * bf2f(vrow[SEQ + pos]); } }
        const float inv = 1.0f / den;
        *(unsigned*)(QB + (size_t)tok * AQ + hd * HD + 2 * C.lane) = pk2(o0 * inv, o1 * inv);
        if (C.lane == 0) LSE[(size_t)tok * NH + hd] = mx + logf(den);
        LDS_WAIT(); asm volatile("" ::: "memory");
    }
}
__device__ __forceinline__ void combine_simple(const Ctx& C, const bf16* QB, const float* LSE, bf16* ATT) {
    for (int tok = C.gw; tok < T; tok += C.NGW) {
#pragma unroll
        for (int h = 0; h < 4; ++h) {
            const float l0 = LSE[(size_t)tok * NH + h], l1 = LSE[(size_t)tok * NH + 4 + h], l2 = LSE[(size_t)tok * NH + 8 + h];
            const float mx = fmaxf(l0, fmaxf(l1, l2)); float w0 = __expf(l0 - mx), w1 = __expf(l1 - mx), w2 = __expf(l2 - mx); const float inv = 1.0f / (w0 + w1 + w2); w0 *= inv; w1 *= inv; w2 *= inv;
            const unsigned a = *(const unsigned*)(QB + (size_t)tok * AQ + h * HD + 2 * C.lane), bq = *(const unsigned*)(QB + (size_t)tok * AQ + (4 + h) * HD + 2 * C.lane), c = *(const unsigned*)(QB + (size_t)tok * AQ + (8 + h) * HD + 2 * C.lane);
            *(unsigned*)(ATT + (size_t)tok * FW + h * HD + 2 * C.lane) = pk2(w0 * pg8::bf_lo(a) + w1 * pg8::bf_lo(bq) + w2 * pg8::bf_lo(c), w0 * pg8::bf_hi(a) + w1 * pg8::bf_hi(bq) + w2 * pg8::bf_hi(c));
        }
    }
}
__device__ __forceinline__ void fft1_simple(const Ctx& C, const bf16* Z1, bf16* YP, const float* COS, const float* SIN) {
    for (int it = C.gw; it < FW * BATCH * 128; it += C.NGW) {
        const int s2 = it & 127, cb = it >> 7, k1 = C.lane;
        const bf16* z = Z1 + (size_t)it * 128;
        float yr = 0.f, yi = 0.f;
        for (int s1 = 0; s1 < 64; ++s1) { const float zr = bf2f(z[s1]), zi = bf2f(z[64 + s1]); const int ix = ((s1 * k1) & 63) * 128; const float c = COS[ix], s = SIN[ix];
            yr += zr * c + zi * s; yi += zi * c - zr * s; }
        const int ix2 = s2 * k1; const float c2 = COS[ix2], sn2 = SIN[ix2];
        const float pr = yr * c2 + yi * sn2, pi = yi * c2 - yr * sn2;
        bf16* o = YP + ((size_t)(cb * 64 + k1) * 2) * 128 + s2;
        o[0] = (bf16)f2bf(pr); o[128] = (bf16)f2bf(pi);
    }
}
__device__ __forceinline__ void fft2_simple(const Ctx& C, const bf16* YP, bf16* FOUR, const float* COS, const float* SIN) {
    for (int it = C.gw; it < BATCH * 64 * FW; it += C.NGW) {
        const int ch = it & 511, k1 = (it >> 9) & 63, b = it >> 15;
        const bf16* y = YP + ((size_t)((ch * 4 + b) * 64 + k1) * 2) * 128;
        float a0 = 0.f, a1 = 0.f;
        for (int s2 = 0; s2 < 128; ++s2) { const float yr = bf2f(y[s2]), yi = bf2f(y[128 + s2]); const int i0 = ((s2 * C.lane) & 127) * 64, i1 = ((s2 * (C.lane + 64)) & 127) * 64;
            a0 += yr * COS[i0] + yi * SIN[i0]; a1 += yr * COS[i1] + yi * SIN[i1]; }
        FOUR[(size_t)(b * SEQ + k1 + 64 * C.lane) * FW + ch] = (bf16)f2bf(a0 * (1.0f / 1024.0f));
        FOUR[(size_t)(b * SEQ + k1 + 64 * (C.lane + 64)) * FW + ch] = (bf16)f2bf(a1 * (1.0f / 1024.0f));
    }
}

struct Args { const float* in[19]; float* out; unsigned char* ws; int ph_lo, ph_hi, li, pad; };
__global__ void __launch_bounds__(NWAVES * 64, 2) mk_fwd(Args args) {
    extern __shared__ __attribute__((aligned(16))) unsigned char lds_raw[];
    Ctx C; C.lds = (LAS unsigned char*)lds_raw; C.tid = threadIdx.x; C.lane = C.tid & 63; C.wave = __builtin_amdgcn_readfirstlane(C.tid >> 6);
    C.G = gridDim.x; const int bx = blockIdx.x; const int vcu = (C.G % 8 == 0) ? (bx % 8) * (C.G / 8) + bx / 8 : bx;
    C.gw = vcu * NWAVES + C.wave; C.NGW = C.G * NWAVES;
    volatile LAS unsigned* MISC = (volatile LAS unsigned*)(C.lds + MISC_OFF);
    unsigned char* ws = args.ws;
    unsigned* ctl = (unsigned*)(ws + WS_CTL);
    for (int u = C.tid; u < (LDS_BYTES - LDSCTL_OFF) / 4; u += NWAVES * 64) ((LAS unsigned*)(C.lds + LDSCTL_OFF))[u] = 0u;
    __syncthreads();
    XcdBarrier bar; bar.bar = ctl + CW_BAR; bar.x = 0; bar.st = nullptr;
    if (N_LAUNCHES == 1) bar = xcd_barrier_post(ctl + CW_BAR, MISC + 8);
    Inputs I; { const float* const* p = args.in; I.x = p[0]; I.ln1g = p[1]; I.ln1b = p[2]; I.w1g = p[3]; I.w1u = p[4]; I.w1d = p[5]; I.win = p[6]; I.bin = p[7]; I.relb = p[8]; I.wpa = p[9]; I.wpf = p[10]; I.wout = p[11];
        I.ln2g = p[12]; I.ln2b = p[13]; I.w2g = p[14]; I.w2u = p[15]; I.w2d = p[16]; I.ln3g = p[17]; I.ln3b = p[18]; }
    float* OUT = args.out;
    bf16* W1A = (bf16*)(ws + WS_W1A); bf16* W1D = (bf16*)(ws + WS_W1D); bf16* W2A = (bf16*)(ws + WS_W2A); bf16* W2D = (bf16*)(ws + WS_W2D);
    bf16* WIN = (bf16*)(ws + WS_WIN); bf16* WSW = (bf16*)(ws + WS_WSW); bf16* WPA = (bf16*)(ws + WS_WPA); bf16* WOUT = (bf16*)(ws + WS_WOUT);
    float* BIASN = (float*)(ws + WS_TAB + TAB_BIASN); float* BIASW = (float*)(ws + WS_TAB + TAB_BIASW); float* TBL = (float*)(ws + WS_TAB + TAB_TBL);
    float* COS = (float*)(ws + WS_TAB + TAB_COS); float* SIN = (float*)(ws + WS_TAB + TAB_SIN); float* LSE = (float*)(ws + WS_TAB + TAB_LSE);
    bf16* XB = (bf16*)(ws + WS_XB); bf16* ACT = (bf16*)(ws + WS_ACT); bf16* QB = (bf16*)(ws + WS_QB); bf16* KB = (bf16*)(ws + WS_KB); bf16* VT = (bf16*)(ws + WS_VT);
    bf16* ATT = (bf16*)(ws + WS_ATT); bf16* FOUR = (bf16*)(ws + WS_FOUR); bf16* MRG = (bf16*)(ws + WS_MRG); bf16* YP = (bf16*)(ws + WS_YP); bf16* Z1 = (bf16*)(ws + WS_Z1);
    bf16* GATES = (bf16*)OUT;
    LAS unsigned char* ring = C.lds + RING_OFF;

    const int lo = args.ph_lo, hi = args.ph_hi;
#define IN(k) (lo <= (k) && (k) < hi)
#define SEAM(k) do { if (IN(k) && IN((k) + 1)) xcd_barrier(bar); } while (0)
    if (IN(0)) { p0_prologue(C, I, ws); VM_WAIT(); __syncthreads(); } SEAM(0);
    if (IN(1)) { SchedStd S{XB, W1A, D, D, T / 256, NUP / 256, C.G, bx}; EpiSwiGLU E{ACT}; pg8::gemm_phase(ring, D, S, E); } SEAM(1);
    if (IN(2)) { SchedStd S{ACT, W1D, FFP, FFP, T / 256, D / 256, C.G, bx}; EpiDown E{I.x, OUT}; pg8::gemm_phase(ring, FFP, S, E); } SEAM(2);
    if (IN(3)) { ln_pass(C, OUT, nullptr, XB, I.ln1g, I.ln1b); } SEAM(3);
    if (IN(4)) { { SchedStd S{XB, WIN, D, D, T / 256, NIN / 256, C.G, bx}; EpiInproj E{QB, KB, GATES, BIASN}; pg8::gemm_phase(ring, D, S, E); }
                 { SchedSw S{WSW, XB, C.G, bx}; EpiSw E{VT, Z1, BIASW}; pg8::gemm_phase(ring, D, S, E); } } SEAM(4);
    if (IN(5)) { attn_simple(C, QB, KB, VT, LSE, TBL); } SEAM(5);
    if (IN(6)) { combine_simple(C, QB, LSE, ATT); fft1_simple(C, Z1, YP, COS, SIN); } SEAM(6);
    if (IN(7)) { fft2_simple(C, YP, FOUR, COS, SIN); } SEAM(7);
    if (IN(8)) { SchedProj S{ATT, WPA, C.G, bx}; EpiProj E{GATES, MRG}; pg8::gemm_phase(ring, FW, S, E); } SEAM(8);
    if (IN(9)) { SchedStd S{MRG, WOUT, D, D, T / 256, D / 256, C.G, bx}; EpiWout E{XB, OUT}; pg8::gemm_phase(ring, D, S, E); } SEAM(9);
    if (IN(10)) { ln_pass(C, OUT, OUT, XB, I.ln2g, I.ln2b); } SEAM(10);
    if (IN(11)) { SchedStd S{XB, W2A, D, D, T / 256, NUP / 256, C.G, bx}; EpiSwiGLU E{ACT}; pg8::gemm_phase(ring, D, S, E); } SEAM(11);
    if (IN(12)) { SchedStd S{ACT, W2D, FFP, FFP, T / 256, D / 256, C.G, bx}; EpiDown E{OUT, OUT}; pg8::gemm_phase(ring, FFP, S, E); } SEAM(12);
    if (IN(13)) { ln_pass(C, OUT, OUT, nullptr, I.ln3g, I.ln3b); }
#undef IN
#undef SEAM
}

extern "C" void kernel_launch(void* const* d_in, const int* in_sizes, int n_in, void* d_out, int out_size, void* d_ws, size_t ws_size, hipStream_t stream) {
    static int grid = 0;
    if (grid == 0) {
        if (n_in != 19 || out_size != T * D || ws_size < WS_END) { fprintf(stderr, "kernel_launch: unexpected shapes (n_in %d, out %d, ws %zu); nothing launched\n", n_in, out_size, ws_size); grid = -1; return; }
        int dev = 0, cus = 0, per_cu = 0;
        if (hipGetDevice(&dev) != hipSuccess || hipDeviceGetAttribute(&cus, hipDeviceAttributeMultiprocessorCount, dev) != hipSuccess) { grid = -1; return; }
        if (hipFuncSetAttribute((const void*)mk_fwd, hipFuncAttributeMaxDynamicSharedMemorySize, LDS_BYTES) != hipSuccess) { fprintf(stderr, "kernel_launch: hipFuncSetAttribute failed\n"); grid = -1; return; }
        if (hipOccupancyMaxActiveBlocksPerMultiprocessor(&per_cu, (const void*)mk_fwd, NWAVES * 64, LDS_BYTES) != hipSuccess || per_cu < 1) fprintf(stderr, "kernel_launch: occupancy query reports %d\n", per_cu);
        (void)hipGetLastError();
        grid = cus;
    }
    if (grid < 0) return;
    if (hipMemsetAsync((char*)d_ws + WS_CTL, 0, CTL_ZERO_BYTES, stream) != hipSuccess) return;
    Args a{};
    for (int i = 0; i < 19; ++i) a.in[i] = (const float*)d_in[i];
    a.out = (float*)d_out; a.ws = (unsigned char*)d_ws;
    if (N_LAUNCHES == 1) { a.ph_lo = 0; a.ph_hi = N_PHASES; a.li = 0; hipLaunchKernelGGL(mk_fwd, dim3(grid), dim3(NWAVES * 64), LDS_BYTES, stream, a); }
    else for (int li = 0; li < N_PHASES; ++li) { a.ph_lo = li; a.ph_hi = li + 1; a.li = li; hipLaunchKernelGGL(mk_fwd, dim3(grid), dim3(NWAVES * 64), LDS_BYTES, stream, a); }
}
```

```cpp
#include <hip/hip_runtime.h>
#include <cstdio>
#include <cstdint>

#ifndef MK_N_LAUNCHES
#define MK_N_LAUNCHES 1
#endif

namespace pg8 {
#define PG8_LAS __attribute__((address_space(3)))
typedef unsigned short bf16_t;
typedef short bf16x8 __attribute__((ext_vector_type(8)));
typedef float f32x4 __attribute__((ext_vector_type(4)));
typedef float f32x2 __attribute__((ext_vector_type(2)));
typedef unsigned u32x4 __attribute__((ext_vector_type(4)));
typedef unsigned u32x2 __attribute__((ext_vector_type(2)));
constexpr int BM = 256, BK = 64, HALF = 128, HTB = HALF * BK * 2, STAGE_BYTES = 8 * HTB, NXCD = 8, WGM = 8;

__host__ __device__ __forceinline__ int lds_byte(int r, int c) { const int st = (r >> 4) * 2 + (c >> 5), rr = r & 15, cc = c & 31, ob = rr * 64 + cc * 2; return st * 1024 + (ob ^ (((ob >> 9) & 1) << 5)); }
__host__ __device__ __forceinline__ void stage_rc(int b, int& R, int& C) { const int st = b / 1024, sb = b % 1024, swz = sb ^ (((sb >> 9) & 1) << 5); R = (st >> 1) * 16 + swz / 64; C = (st & 1) * 32 + (swz % 64) / 2; }
__host__ __device__ __forceinline__ int perm32(int rho) { const int n = rho >> 4, i = rho & 15; return 8 * (i >> 2) + 4 * n + (i & 3); }

struct Unit { int pm, pn, kind; };

__device__ __forceinline__ void tile_of(int L, int nM, int nN, int& pm, int& pn) {
    const int nwg = nM * nN; int wgid = L;
    { const int q = nwg / NXCD, r = nwg % NXCD, xcd = wgid % NXCD, off = wgid / NXCD; wgid = (xcd < r ? xcd * (q + 1) : r * (q + 1) + (xcd - r) * q) + off; }
    const int nig = WGM * nN, gid = wgid / nig, fm = gid * WGM, gsz = (nM - fm) < WGM ? (nM - fm) : WGM;
    pm = fm + ((wgid % nig) % gsz); pn = (wgid % nig) / gsz;
}

__device__ __forceinline__ unsigned cvt_pk_bf16(float lo, float hi) { unsigned r; asm volatile("v_cvt_pk_bf16_f32 %0, %1, %2" : "=v"(r) : "v"(lo), "v"(hi)); return r; }
__device__ __forceinline__ float bf_lo(unsigned w) { return __uint_as_float(w << 16); }
__device__ __forceinline__ float bf_hi(unsigned w) { return __uint_as_float(w & 0xffff0000u); }

template <class Epi, class Sched>
__device__ __forceinline__ void gemm_phase(PG8_LAS unsigned char* lds, const int K, const Sched& S, const Epi& E) {
    const int tid = threadIdx.x, wid = __builtin_amdgcn_readfirstlane(tid >> 6), lane = tid & 63, wr = wid >> 2, wc = wid & 3, fr = lane & 15, fq = lane >> 4;
    const int nt = K / BK;
    const int lda = S.lda(), ldb = S.ldb();
    unsigned voffA[2], cvB[2], nvB[2];
    Unit cur, nxt; int ui = 0;
    if (!S.next(0, cur)) return;
#define PG8_VB(dst, u) do { _Pragma("unroll") for (int _i = 0; _i < 2; ++_i) { int R_, C_; stage_rc(tid * 16 + _i * 8192, R_, C_); const int Rb_ = Epi::PERM ? ((R_ & ~31) + perm32(R_ & 31)) : R_; \
        if constexpr (Sched::GATHER) dst[_i] = (unsigned)(S.btok(u, Rb_) * ldb + C_) * 2u; else dst[_i] = (unsigned)(Rb_ * ldb + C_) * 2u; } } while (0)
#pragma unroll
    for (int i = 0; i < 2; ++i) { int R, C; stage_rc(tid * 16 + i * 8192, R, C); voffA[i] = (unsigned)(R * lda + C) * 2u; }
    PG8_VB(cvB, cur);
    const size_t kstep = (size_t)(BK * 2);
    const size_t hstepA = (size_t)HALF * lda * 2;
    size_t chB, nhB;
    if constexpr (Sched::GATHER) chB = S.bhalf(cur); else chB = (size_t)HALF * ldb * 2;
    nhB = chB; nvB[0] = cvB[0]; nvB[1] = cvB[1];
    const unsigned ldsw = (unsigned)wid * 1024u;
    const int aoff = lds_byte(wr * 64 + fr, fq * 8), boff = lds_byte(wc * 32 + fr, fq * 8);
#define PG8_SA(b, h) (((b) * 2 + (h)) * HTB)
#define PG8_SB(b, h) ((4 + (b) * 2 + (h)) * HTB)
#define PG8_STAGE(bufoff, gbase, v0, v1) do { \
        __builtin_amdgcn_global_load_lds((const unsigned*)((const char*)(gbase) + (v0)), (PG8_LAS unsigned*)(lds + (bufoff) + ldsw), 16, 0, 0); \
        __builtin_amdgcn_global_load_lds((const unsigned*)((const char*)(gbase) + (v1)), (PG8_LAS unsigned*)(lds + (bufoff) + ldsw + 8192), 16, 0, 0); } while (0)
#define PG8_STA(bufoff, gbase) PG8_STAGE(bufoff, gbase, voffA[0], voffA[1])
#define PG8_LDA(dst, b, h) do { _Pragma("unroll") for (int m = 0; m < 4; ++m) _Pragma("unroll") for (int k = 0; k < 2; ++k) dst[m][k] = *(const PG8_LAS bf16x8*)(lds + PG8_SA(b, h) + aoff + m * 2048 + k * 1024); } while (0)
#define PG8_LDB(dst, b, h) do { _Pragma("unroll") for (int n = 0; n < 2; ++n) _Pragma("unroll") for (int k = 0; k < 2; ++k) dst[n][k] = *(const PG8_LAS bf16x8*)(lds + PG8_SB(b, h) + boff + n * 2048 + k * 1024); } while (0)
#define PG8_MMA(ai, bj, At, Bt) do { __builtin_amdgcn_s_setprio(1); _Pragma("unroll") for (int m = 0; m < 4; ++m) _Pragma("unroll") for (int n = 0; n < 2; ++n) _Pragma("unroll") for (int k = 0; k < 2; ++k) \
        acc[ai][bj][m][n] = __builtin_amdgcn_mfma_f32_16x16x32_bf16(Bt[n][k], At[m][k], acc[ai][bj][m][n], 0, 0, 0); __builtin_amdgcn_s_setprio(0); } while (0)
#define PG8_WAIT_V(n) asm volatile("s_waitcnt vmcnt(" #n ")" ::: "memory")
#define PG8_WAIT_L(n) asm volatile("s_waitcnt lgkmcnt(" #n ")" ::: "memory")
#define PG8_BAR __builtin_amdgcn_s_barrier()
#define PG8_SCHED __builtin_amdgcn_sched_barrier(0)
    f32x4 acc[2][2][4][2];
#pragma unroll
    for (int a = 0; a < 2; ++a)
#pragma unroll
        for (int b = 0; b < 2; ++b)
#pragma unroll
            for (int m = 0; m < 4; ++m)
#pragma unroll
                for (int n = 0; n < 2; ++n) acc[a][b][m][n] = (f32x4){0.f, 0.f, 0.f, 0.f};
    bf16x8 At[4][2], B0[2][2], B1[2][2];
    const char* cA = S.abase(cur); const char* cB = S.bbase(cur);
    PG8_STAGE(PG8_SB(0, 0), cB, cvB[0], cvB[1]); PG8_STAGE(PG8_SB(0, 1), cB + chB, cvB[0], cvB[1]); PG8_STA(PG8_SA(0, 0), cA); PG8_STA(PG8_SA(0, 1), cA + hstepA);
    if (wr == 1) PG8_BAR;
    PG8_WAIT_V(2); PG8_BAR;
    PG8_STAGE(PG8_SB(1, 0), cB + kstep, cvB[0], cvB[1]); PG8_STA(PG8_SA(1, 0), cA + kstep); PG8_STAGE(PG8_SB(1, 1), cB + chB + kstep, cvB[0], cvB[1]);
    PG8_WAIT_V(6); PG8_BAR;
    for (;;) {
        const bool has_next = S.next(ui + 1, nxt);
        const char* nA = has_next ? S.abase(nxt) : cA; const char* nB = has_next ? S.bbase(nxt) : cB;
        if constexpr (Sched::GATHER) { if (has_next) { PG8_VB(nvB, nxt); nhB = S.bhalf(nxt); } else { nvB[0] = cvB[0]; nvB[1] = cvB[1]; nhB = chB; } }
        for (int t = 0; t < nt; t += 2) {
            const bool last = (t == nt - 2);
            const char* a1 = cA + (size_t)(t + 1) * kstep;
            const char* a2 = last ? nA : cA + (size_t)(t + 2) * kstep; const char* b2 = last ? nB : cB + (size_t)(t + 2) * kstep;
            const char* a3 = a2 + kstep; const char* b3 = b2 + kstep;
            unsigned v20, v21; size_t h2;
            if constexpr (Sched::GATHER) { v20 = last ? nvB[0] : cvB[0]; v21 = last ? nvB[1] : cvB[1]; h2 = last ? nhB : chB; } else { v20 = cvB[0]; v21 = cvB[1]; h2 = chB; }
            PG8_LDB(B0, 0, 0); PG8_LDB(B1, 0, 1); PG8_SCHED; PG8_LDA(At, 0, 0); PG8_STA(PG8_SA(1, 1), a1 + hstepA);
            PG8_WAIT_V(8); PG8_WAIT_L(0); PG8_BAR; PG8_MMA(0, 0, At, B0); PG8_MMA(0, 1, At, B1); PG8_BAR; PG8_SCHED;
            PG8_LDA(At, 0, 1); PG8_STAGE(PG8_SB(0, 0), b2, v20, v21); PG8_STAGE(PG8_SB(0, 1), b2 + h2, v20, v21); PG8_STA(PG8_SA(0, 0), a2);
            PG8_WAIT_V(8); PG8_WAIT_L(0); PG8_BAR; PG8_MMA(1, 0, At, B0); PG8_MMA(1, 1, At, B1); PG8_BAR; PG8_SCHED;
            PG8_LDB(B0, 1, 0); PG8_LDB(B1, 1, 1); PG8_SCHED; PG8_LDA(At, 1, 0); PG8_STA(PG8_SA(0, 1), a2 + hstepA);
            PG8_WAIT_V(8); PG8_WAIT_L(0); PG8_BAR; PG8_MMA(0, 0, At, B0); PG8_MMA(0, 1, At, B1); PG8_BAR; PG8_SCHED;
            PG8_LDA(At, 1, 1); PG8_STAGE(PG8_SB(1, 0), b3, v20, v21); PG8_STAGE(PG8_SB(1, 1), b3 + h2, v20, v21); PG8_STA(PG8_SA(1, 0), a3);
            PG8_WAIT_V(8); PG8_WAIT_L(0); PG8_BAR; PG8_MMA(1, 0, At, B0); PG8_MMA(1, 1, At, B1); PG8_BAR; PG8_SCHED;
        }
        if (wr == 0) PG8_BAR;
        E(acc, cur, wr, wc, fr, fq);
        if (!has_next) break;
#pragma unroll
        for (int a = 0; a < 2; ++a)
#pragma unroll
            for (int b = 0; b < 2; ++b)
#pragma unroll
                for (int m = 0; m < 4; ++m)
#pragma unroll
                    for (int n = 0; n < 2; ++n) acc[a][b][m][n] = (f32x4){0.f, 0.f, 0.f, 0.f};
        cur = nxt; cA = nA; cB = nB; ++ui;
        if constexpr (Sched::GATHER) { cvB[0] = nvB[0]; cvB[1] = nvB[1]; chB = nhB; }
        if (wr == 1) PG8_BAR;
    }
    PG8_WAIT_V(0);
    PG8_BAR;
#undef PG8_VB
#undef PG8_SA
#undef PG8_SB
#undef PG8_STAGE
#undef PG8_STA
#undef PG8_LDA
#undef PG8_LDB
#undef PG8_MMA
#undef PG8_WAIT_V
#undef PG8_WAIT_L
#undef PG8_BAR
#undef PG8_SCHED
}
}

constexpr int NWAVES = 8;
constexpr int N_LAUNCHES = MK_N_LAUNCHES;
constexpr int N_PHASES = 14;
constexpr int BATCH = 4, SEQ = 8192, T = BATCH * SEQ, D = 1024, FF = 2752, FFP = 2816, NUP = 2 * FFP;
constexpr int NH = 12, HD = 128, AQ = NH * HD;
constexpr int FW = 512;
constexpr int NIN = 2 * AQ + 2 * D;
constexpr int NSW = AQ + 2 * FW;
constexpr float LN_EPS = 1e-5f;
constexpr float ALPHA = 1.18920711500272f;
constexpr float QSCALE = 0.08838834764831845f;

constexpr size_t MiB = 1u << 20;
constexpr size_t WS_CTL = 0, CTL_ZERO_BYTES = 1 * MiB;
constexpr size_t WS_W1A = 1 * MiB, WS_W1D = 12 * MiB, WS_W2A = 18 * MiB, WS_W2D = 29 * MiB, WS_WIN = 35 * MiB, WS_WSW = 45 * MiB, WS_WPA = 50 * MiB, WS_WPF = 51 * MiB, WS_WOUT = 52 * MiB;
constexpr size_t WS_TAB = 54 * MiB;
constexpr size_t TAB_BIASN = 0, TAB_BIASW = 32768, TAB_TBL = 65536, TAB_COS = 81920, TAB_SIN = 81920 + 32768, TAB_LSE = 1 * MiB;
constexpr size_t WS_XB = 58 * MiB;
constexpr size_t WS_BIG = 122 * MiB;
constexpr size_t WS_ACT = WS_BIG;
constexpr size_t WS_QB = WS_BIG, WS_KB = WS_BIG + 96 * MiB, WS_VT = WS_BIG + 192 * MiB;
constexpr size_t WS_ATT = WS_KB, WS_FOUR = WS_KB + 32 * MiB, WS_MRG = WS_KB + 64 * MiB, WS_YP = WS_KB + 128 * MiB;
constexpr size_t WS_Z1 = 410 * MiB, WS_END = 474 * MiB;
static_assert(WS_YP + 64 * MiB <= WS_Z1 && WS_MRG + 64 * MiB <= WS_YP && WS_ACT + (size_t)T * FFP * 2 <= WS_Z1, "d_ws map");
constexpr int CW_BAR = 4096;

constexpr int RING_OFF = 0, RING_BYTES = 131072;
constexpr int LDSCTL_OFF = RING_BYTES, MISC_OFF = LDSCTL_OFF + 320, LTAB_OFF = RING_BYTES + 1024;
constexpr int LDS_BYTES = 147456;

#define GAS __attribute__((address_space(1)))
#define LAS __attribute__((address_space(3)))
typedef unsigned short bf16;
typedef unsigned v4u __attribute__((ext_vector_type(4)));
typedef unsigned v2u __attribute__((ext_vector_type(2)));
typedef float f32x4 __attribute__((ext_vector_type(4)));
#define RLX_AGENT __ATOMIC_RELAXED, __HIP_MEMORY_SCOPE_AGENT
#define LDS_WAIT() asm volatile("s_waitcnt lgkmcnt(0)" ::: "memory")
#define VM_WAIT() asm volatile("s_waitcnt vmcnt(0)" ::: "memory")
__device__ __forceinline__ unsigned f2bf(float f) { unsigned u = __builtin_bit_cast(unsigned, f); return (u + 0x7fffu + ((u >> 16) & 1u)) >> 16; }
__device__ __forceinline__ unsigned pk2(float lo, float hi) { return f2bf(lo) | (f2bf(hi) << 16); }
__device__ __forceinline__ float bf2f(unsigned short h) { return __uint_as_float(((unsigned)h) << 16); }

#define XB_TMO      128
#define XB_XCNT(j)  (256  + 64 * (j))
#define XB_XSUB(j)  (1280 + 64 * (j))
#define XB_XGEN(j)  (2304 + 64 * (j))
#define XB_TOP      3328
#define XB_TOPGEN   3392
#define XCD_BAR_WORDS 3456
#define XB_SPIN_CAP (1u << 18)
__device__ __forceinline__ unsigned xb_ld(unsigned* p)              { return __hip_atomic_load(p, __ATOMIC_RELAXED, __HIP_MEMORY_SCOPE_AGENT); }
__device__ __forceinline__ unsigned xb_add(unsigned* p, unsigned v) { return __hip_atomic_fetch_add(p, v, __ATOMIC_RELAXED, __HIP_MEMORY_SCOPE_AGENT); }
__device__ __forceinline__ unsigned xb_xcc_id() { return (unsigned)__builtin_amdgcn_s_getreg((3 << 11) | 20) & 0xFu; }
#define XB_SPIN(cond, bar) do { unsigned _sp = 0; while (cond) { __builtin_amdgcn_s_sleep(1); \
    if ((++_sp & 255u) == 0u) { if (xb_ld(&(bar)[XB_TMO])) break; if (_sp > XB_SPIN_CAP) { atomicAdd(&(bar)[XB_TMO], 1u); break; } } } } while (0)
struct XcdBarrier { unsigned* bar; unsigned x; volatile LAS unsigned* st; };
__device__ __forceinline__ XcdBarrier xcd_barrier_post(unsigned* bar, volatile LAS unsigned* st) {
    XcdBarrier b; b.bar = bar; b.x = xb_xcc_id(); b.st = st;
    if (threadIdx.x == 0) (void)xb_add(&bar[XB_XCNT(b.x)], 1u);
    return b;
}
__device__ __forceinline__ void xcd_barrier_complete(unsigned* bar, unsigned x, unsigned& nloc, unsigned& nx) {
    const unsigned G = gridDim.x * gridDim.y * gridDim.z;
    unsigned sum, cnt, mine, sp = 0u;
    for (;;) {
        sum = 0u; cnt = 0u; mine = 0u;
#pragma unroll
        for (unsigned j = 0; j < 16; ++j) { const unsigned c = xb_ld(&bar[XB_XCNT(j)]); sum += c; cnt += (c > 0u) ? 1u : 0u; mine = (j == x) ? c : mine; }
        if (sum == G) break;
        __builtin_amdgcn_s_sleep(1);
        if ((++sp & 255u) == 0u) { if (xb_ld(&bar[XB_TMO])) break; if (sp > XB_SPIN_CAP) { atomicAdd(&bar[XB_TMO], 1u); break; } }
    }
    nloc = mine > 0u ? mine : 1u; nx = cnt > 0u ? cnt : 1u;
}
__device__ __forceinline__ void xcd_barrier(const XcdBarrier& b) {
    asm volatile("s_waitcnt vmcnt(0)" ::: "memory");
    __syncthreads();
    if (threadIdx.x == 0) {
        unsigned* bar = b.bar;
        __builtin_amdgcn_s_waitcnt(0);
        unsigned nloc = b.st[0], nx = b.st[1];
        if (nloc == 0u) { xcd_barrier_complete(bar, b.x, nloc, nx); b.st[0] = nloc; b.st[1] = nx; }
        const unsigned old = xb_add(&bar[XB_XSUB(b.x)], 1u);
        const unsigned gen = old / nloc;
        if (old + 1u == (gen + 1u) * nloc) {
            __builtin_amdgcn_fence(__ATOMIC_RELEASE, "agent");
            asm volatile("s_waitcnt vmcnt(0)" ::: "memory");
            const unsigned og = xb_add(&bar[XB_TOP], 1u);
            const unsigned tg = og / nx;
            if (og + 1u == (tg + 1u) * nx) xb_add(&bar[XB_TOPGEN], 1u);
            else XB_SPIN(xb_ld(&bar[XB_TOPGEN]) == tg, bar);
            __builtin_amdgcn_fence(__ATOMIC_ACQUIRE, "agent");
            xb_add(&bar[XB_XGEN(b.x)], 1u);
            asm volatile("s_waitcnt vmcnt(0)" ::: "memory");
        } else {
            XB_SPIN(xb_ld(&bar[XB_XGEN(b.x)]) == gen, bar);
            __builtin_amdgcn_fence(__ATOMIC_ACQUIRE, "agent");
            asm volatile("s_waitcnt vmcnt(0)" ::: "memory");
        }
    }
    __syncthreads();
}

struct SchedStd {
    static constexpr bool GATHER = false;
    const bf16* A; const bf16* Bt; int lda_, ldb_, nM, nN, G, c;
    __device__ __forceinline__ int lda() const { return lda_; }
    __device__ __forceinline__ int ldb() const { return ldb_; }
    __device__ __forceinline__ bool next(int i, pg8::Unit& u) const { const long L = (long)i * G + c; if (L >= (long)nM * nN) return false; pg8::tile_of((int)L, nM, nN, u.pm, u.pn); u.kind = 0; return true; }
    __device__ __forceinline__ const char* abase(const pg8::Unit& u) const { return (const char*)A + (size_t)u.pm * 256 * lda_ * 2; }
    __device__ __forceinline__ const char* bbase(const pg8::Unit& u) const { return (const char*)Bt + (size_t)u.pn * 256 * ldb_ * 2; }
    __device__ __forceinline__ int btok(const pg8::Unit&, int j) const { return j; }
    __device__ __forceinline__ size_t bhalf(const pg8::Unit&) const { return (size_t)128 * ldb_ * 2; }
};
struct SchedProj {
    static constexpr bool GATHER = false;
    const bf16* ATT; const bf16* WPA; int G, c;
    __device__ __forceinline__ int lda() const { return FW; }
    __device__ __forceinline__ int ldb() const { return FW; }
    __device__ __forceinline__ bool next(int i, pg8::Unit& u) const { const long L = (long)(i >> 1) * G + c; if (L >= (long)(T / 256) * (D / 256)) return false; pg8::tile_of((int)L, T / 256, D / 256, u.pm, u.pn); u.kind = i & 1; return true; }
    __device__ __forceinline__ const char* abase(const pg8::Unit& u) const { return (const char*)ATT + ((size_t)u.kind * T * FW + (size_t)u.pm * 256 * FW) * 2; }
    __device__ __forceinline__ const char* bbase(const pg8::Unit& u) const { return (const char*)WPA + ((size_t)u.kind * D * FW + (size_t)u.pn * 256 * FW) * 2; }
    __device__ __forceinline__ int btok(const pg8::Unit&, int j) const { return j; }
    __device__ __forceinline__ size_t bhalf(const pg8::Unit&) const { return (size_t)128 * FW * 2; }
};
__device__ __forceinline__ int swap23(int j) { return (j & ~12) | ((j & 4) << 1) | ((j & 8) >> 1); }
struct SchedSw {
    static constexpr bool GATHER = true;
    const bf16* WSW; const bf16* H1; int G, c;
    __device__ __forceinline__ int lda() const { return D; }
    __device__ __forceinline__ int ldb() const { return D; }
    __device__ __forceinline__ bool next(int i, pg8::Unit& u) const { const long L = (long)i * G + c; if (L >= (long)(NSW / 256) * (T / 256)) return false; pg8::tile_of((int)L, NSW / 256, T / 256, u.pm, u.pn); u.kind = 0; return true; }
    __device__ __forceinline__ const char* abase(const pg8::Unit& u) const { return (const char*)WSW + (size_t)u.pm * 256 * D * 2; }
    __device__ __forceinline__ const char* bbase(const pg8::Unit& u) const {
        const int b = u.pn >> 5, nb0 = (u.pn & 31) * 256; int tok0;
        if (u.pm < 6) { const int sh = 2 * (u.pm >> 1), L = SEQ >> sh, r = nb0 / L, mp0 = nb0 & (L - 1); tok0 = b * SEQ + (mp0 << sh) + r; }
        else tok0 = b * SEQ + (u.pn & 31) * 4;
        return (const char*)H1 + (size_t)tok0 * D * 2;
    }
    __device__ __forceinline__ int btok(const pg8::Unit& u, int j) const { return (u.pm < 6) ? (swap23(j) << (2 * (u.pm >> 1))) : (128 * (j & 63) + (j >> 6)); }
    __device__ __forceinline__ size_t bhalf(const pg8::Unit& u) const { return (u.pm < 6) ? ((size_t)(128 << (2 * (u.pm >> 1))) * D * 2) : ((size_t)2 * D * 2); }
};

using pg8::f32x2;
__device__ __forceinline__ float sigmoidf_(float v) { return __builtin_amdgcn_rcpf(1.0f + __builtin_amdgcn_exp2f(-1.4426950408889634f * v)); }
struct EpiSwiGLU {
    static constexpr bool PERM = true;
    bf16* O;
    __device__ __forceinline__ void operator()(const f32x4 (&acc)[2][2][4][2], const pg8::Unit& u, int wr, int wc, int fr, int fq) const {
        const int row0 = u.pm * 256 + wr * 64 + fr, col0 = u.pn * 128 + wc * 32 + 8 * fq;
#pragma unroll
        for (int ai = 0; ai < 2; ++ai)
#pragma unroll
            for (int m = 0; m < 4; ++m) {
                float o[8];
#pragma unroll
                for (int n = 0; n < 2; ++n)
#pragma unroll
                    for (int j = 0; j < 4; ++j) { const float g = acc[ai][0][m][n][j], up = acc[ai][1][m][n][j]; o[4 * n + j] = g * sigmoidf_(g) * up; }
                v4u w; w.x = pg8::cvt_pk_bf16(o[0], o[1]); w.y = pg8::cvt_pk_bf16(o[2], o[3]); w.z = pg8::cvt_pk_bf16(o[4], o[5]); w.w = pg8::cvt_pk_bf16(o[6], o[7]);
                *(v4u*)(O + (size_t)(row0 + ai * 128 + m * 16) * FFP + col0) = w; }
    }
};
struct EpiInproj {
    static constexpr bool PERM = true;
    bf16* QB; bf16* KB; bf16* GATES; const float* bias;
    __device__ __forceinline__ void operator()(const f32x4 (&acc)[2][2][4][2], const pg8::Unit& u, int wr, int wc, int fr, int fq) const {
        const int row0 = u.pm * 256 + wr * 64 + fr, cw = wc * 32 + 8 * fq;
        bf16* base; int ldc, mode;
        if (u.pn < 6) { base = QB + u.pn * 256; ldc = AQ; mode = 0; } else if (u.pn < 12) { base = KB + (u.pn - 6) * 256; ldc = AQ; mode = 1; } else { base = GATES + (u.pn - 12) * 256; ldc = 2 * D; mode = 2; }
        f32x4 bv[2][2];
#pragma unroll
        for (int bj = 0; bj < 2; ++bj)
#pragma unroll
            for (int n = 0; n < 2; ++n) bv[bj][n] = *(const f32x4*)(bias + u.pn * 256 + bj * 128 + cw + 4 * n);
#pragma unroll
        for (int ai = 0; ai < 2; ++ai)
#pragma unroll
            for (int m = 0; m < 4; ++m) { bf16* rowp = base + (size_t)(row0 + ai * 128 + m * 16) * ldc + cw;
#pragma unroll
                for (int bj = 0; bj < 2; ++bj) { f32x4 v0 = acc[ai][bj][m][0] + bv[bj][0], v1 = acc[ai][bj][m][1] + bv[bj][1];
                    if (mode == 0) { v0 = v0 * QSCALE; v1 = v1 * QSCALE; }
                    if (mode == 2) {
#pragma unroll
                        for (int j = 0; j < 4; ++j) { v0[j] = sigmoidf_(v0[j]); v1[j] = sigmoidf_(v1[j]); } }
                    v4u w; w.x = pg8::cvt_pk_bf16(v0[0], v0[1]); w.y = pg8::cvt_pk_bf16(v0[2], v0[3]); w.z = pg8::cvt_pk_bf16(v1[0], v1[1]); w.w = pg8::cvt_pk_bf16(v1[2], v1[3]);
                    *(v4u*)(rowp + bj * 128) = w; } }
    }
};
struct EpiSw {
    static constexpr bool PERM = true;
    bf16* VT; bf16* Z1; const float* bias;
    __device__ __forceinline__ void operator()(const f32x4 (&acc)[2][2][4][2], const pg8::Unit& u, int wr, int wc, int fr, int fq) const {
        const int r0 = u.pm * 256 + wr * 64 + fr, n0 = u.pn * 256 + wc * 32 + 8 * fq;
#pragma unroll
        for (int ai = 0; ai < 2; ++ai)
#pragma unroll
            for (int m = 0; m < 4; ++m) { const int R = r0 + ai * 128 + m * 16; const float bs = bias[R];
#pragma unroll
                for (int bj = 0; bj < 2; ++bj) { const int n = n0 + bj * 128; const f32x4 v0 = acc[ai][bj][m][0] + bs, v1 = acc[ai][bj][m][1] + bs;
                    v4u w; w.x = pg8::cvt_pk_bf16(v0[0], v0[1]); w.y = pg8::cvt_pk_bf16(v0[2], v0[3]); w.z = pg8::cvt_pk_bf16(v1[0], v1[1]); w.w = pg8::cvt_pk_bf16(v1[2], v1[3]);
                    bf16* p;
                    if (u.pm < 6) p = VT + ((size_t)((n >> 13) * AQ + R) * SEQ + (n & (SEQ - 1)));
                    else { const int zr = R - AQ, ri = zr >> 9, ch = zr & 511, b = n >> 13, s2 = (n >> 6) & 127, s1 = n & 63; p = Z1 + ((((size_t)(ch * 4 + b) * 128 + s2) * 2 + ri) * 64 + s1); }
                    *(v4u*)p = w; } }
    }
};
struct EpiDown {
    static constexpr bool PERM = false;
    const float* res; float* out;
    __device__ __forceinline__ void operator()(const f32x4 (&acc)[2][2][4][2], const pg8::Unit& u, int wr, int wc, int fr, int fq) const {
        const int row0 = u.pm * 256 + wr * 64 + fr, col0 = u.pn * 256 + wc * 32 + 4 * fq;
#pragma unroll
        for (int ai = 0; ai < 2; ++ai)
#pragma unroll
            for (int m = 0; m < 4; ++m) { const size_t off = (size_t)(row0 + ai * 128 + m * 16) * D + col0;
#pragma unroll
                for (int bj = 0; bj < 2; ++bj)
#pragma unroll
                    for (int n = 0; n < 2; ++n) { const f32x4 r = *(const f32x4*)(res + off + bj * 128 + n * 16); *(f32x4*)(out + off + bj * 128 + n * 16) = r * ALPHA + acc[ai][bj][m][n] * 0.5f; } }
    }
};
struct EpiWout {
    static constexpr bool PERM = false;
    const bf16* res; float* out;
    __device__ __forceinline__ void operator()(const f32x4 (&acc)[2][2][4][2], const pg8::Unit& u, int wr, int wc, int fr, int fq) const {
        const int row0 = u.pm * 256 + wr * 64 + fr, col0 = u.pn * 256 + wc * 32 + 4 * fq;
#pragma unroll
        for (int ai = 0; ai < 2; ++ai)
#pragma unroll
            for (int m = 0; m < 4; ++m) { const size_t off = (size_t)(row0 + ai * 128 + m * 16) * D + col0;
#pragma unroll
                for (int bj = 0; bj < 2; ++bj)
#pragma unroll
                    for (int n = 0; n < 2; ++n) { const v2u rw = *(const v2u*)(res + off + bj * 128 + n * 16);
                        const f32x4 r = (f32x4){pg8::bf_lo(rw.x), pg8::bf_hi(rw.x), pg8::bf_lo(rw.y), pg8::bf_hi(rw.y)};
                        *(f32x4*)(out + off + bj * 128 + n * 16) = r * ALPHA + acc[ai][bj][m][n]; } }
    }
};
struct EpiProj {
    static constexpr bool PERM = true;
    const bf16* GATES; bf16* MRG;
    __device__ __forceinline__ void operator()(const f32x4 (&acc)[2][2][4][2], const pg8::Unit& u, int wr, int wc, int fr, int fq) const {
        const int row0 = u.pm * 256 + wr * 64 + fr, col0 = u.pn * 256 + wc * 32 + 8 * fq;
#pragma unroll
        for (int ai = 0; ai < 2; ++ai)
#pragma unroll
            for (int m = 0; m < 4; ++m) { const int row = row0 + ai * 128 + m * 16;
#pragma unroll
                for (int bj = 0; bj < 2; ++bj) { const int col = col0 + bj * 128;
                    const v4u gw = *(const v4u*)(GATES + (size_t)row * (2 * D) + u.kind * D + col);
                    float o[8]; const f32x4 a0 = acc[ai][bj][m][0], a1 = acc[ai][bj][m][1];
                    o[0] = pg8::bf_lo(gw.x) * a0[0]; o[1] = pg8::bf_hi(gw.x) * a0[1]; o[2] = pg8::bf_lo(gw.y) * a0[2]; o[3] = pg8::bf_hi(gw.y) * a0[3];
                    o[4] = pg8::bf_lo(gw.z) * a1[0]; o[5] = pg8::bf_hi(gw.z) * a1[1]; o[6] = pg8::bf_lo(gw.w) * a1[2]; o[7] = pg8::bf_hi(gw.w) * a1[3];
                    bf16* p = MRG + (size_t)row * D + col;
                    if (u.kind == 1) {
                        const unsigned long long q0 = __hip_atomic_load((const unsigned long long*)p, RLX_AGENT), q1 = __hip_atomic_load((const unsigned long long*)p + 1, RLX_AGENT);
                        const unsigned w0 = (unsigned)q0, w1 = (unsigned)(q0 >> 32), w2 = (unsigned)q1, w3 = (unsigned)(q1 >> 32);
                        o[0] += pg8::bf_lo(w0); o[1] += pg8::bf_hi(w0); o[2] += pg8::bf_lo(w1); o[3] += pg8::bf_hi(w1); o[4] += pg8::bf_lo(w2); o[5] += pg8::bf_hi(w2); o[6] += pg8::bf_lo(w3); o[7] += pg8::bf_hi(w3); }
                    v4u w; w.x = pg8::cvt_pk_bf16(o[0], o[1]); w.y = pg8::cvt_pk_bf16(o[2], o[3]); w.z = pg8::cvt_pk_bf16(o[4], o[5]); w.w = pg8::cvt_pk_bf16(o[6], o[7]);
                    *(v4u*)p = w; } }
    }
};

struct Ctx { LAS unsigned char* lds; int tid, lane, wave, G, gw, NGW; };
__device__ __forceinline__ float wave_sum(float v) {
#pragma unroll
    for (int o = 1; o < 64; o <<= 1) v += __shfl_xor(v, o);
    return v;
}
template <class RowMap>
__device__ __forceinline__ void tr_item(const float* W, int ldw, int k0, int n0, bf16* WT, int ldt, const RowMap& rm, LAS float* scr, int lane) {
#pragma unroll 8
    for (int i = 0; i < 32; ++i) { const int kk = 2 * i + (lane >> 5); scr[kk * 33 + (lane & 31)] = W[(size_t)(k0 + kk) * ldw + n0 + (lane & 31)]; }
    LDS_WAIT(); asm volatile("" ::: "memory");
    const int c = lane & 7;
#pragma unroll
    for (int j = 0; j < 4; ++j) { const int n = (lane >> 3) + 8 * j; const LAS float* s = scr + (8 * c) * 33 + n;
        v4u o; o.x = pk2(s[0 * 33], s[1 * 33]); o.y = pk2(s[2 * 33], s[3 * 33]); o.z = pk2(s[4 * 33], s[5 * 33]); o.w = pk2(s[6 * 33], s[7 * 33]);
        *(GAS v4u*)(WT + (size_t)rm(n0 + n) * ldt + k0 + 8 * c) = o; }
    LDS_WAIT(); asm volatile("" ::: "memory");
}
template <class RowMap>
__device__ __forceinline__ void tr_matrix(const Ctx& C, const float* W, int ldw, int K, int ncol0, int ncols, bf16* WT, int ldt, const RowMap& rm) {
    LAS float* scr = (LAS float*)(C.lds + RING_OFF + C.wave * 16384);
    const int nblk = ncols / 32, nitems = (K / 64) * nblk;
    for (int it = C.gw; it < nitems; it += C.NGW) { const int kb = it / nblk, nb = it % nblk; tr_item(W, ldw, 64 * kb, ncol0 + 32 * nb, WT, ldt, rm, scr, C.lane); }
}
struct RmOff { int off; __device__ __forceinline__ int operator()(int n) const { return n + off; } };
struct RmGU { int up; __device__ __forceinline__ int operator()(int n) const { return (n >> 7) * 256 + (n & 127) + up; } };

struct Inputs { const float *x, *ln1g, *ln1b, *w1g, *w1u, *w1d, *win, *bin, *relb, *wpa, *wpf, *wout, *ln2g, *ln2b, *w2g, *w2u, *w2d, *ln3g, *ln3b; };

__device__ __forceinline__ int t5_bucket(int rel) {
    const int ret = rel > 0 ? 16 : 0; const int n = rel < 0 ? -rel : rel;
    const float nf = (float)(n > 1 ? n : 1);
    int large = 8 + (int)(logf(nf / 8.0f) / 4.852030263919617f * 8.0f);
    large = large < 15 ? large : 15;
    return ret + (n < 8 ? n : large);
}

__device__ __forceinline__ void p0_prologue(const Ctx& C, const Inputs& I, unsigned char* ws) {
    bf16* W1A = (bf16*)(ws + WS_W1A); bf16* W1D = (bf16*)(ws + WS_W1D); bf16* W2A = (bf16*)(ws + WS_W2A); bf16* W2D = (bf16*)(ws + WS_W2D);
    bf16* WIN = (bf16*)(ws + WS_WIN); bf16* WSW = (bf16*)(ws + WS_WSW); bf16* WPA = (bf16*)(ws + WS_WPA); bf16* WPF = (bf16*)(ws + WS_WPF); bf16* WOUT = (bf16*)(ws + WS_WOUT);
    float* BIASN = (float*)(ws + WS_TAB + TAB_BIASN); float* BIASW = (float*)(ws + WS_TAB + TAB_BIASW); float* TBL = (float*)(ws + WS_TAB + TAB_TBL);
    float* COS = (float*)(ws + WS_TAB + TAB_COS); float* SIN = (float*)(ws + WS_TAB + TAB_SIN);
    bf16* XB = (bf16*)(ws + WS_XB);
    LAS float* lc = (LAS float*)(C.lds + LTAB_OFF); LAS float* ls = lc + 128;
    if (C.tid < 128) { lc[C.tid] = cospif((float)C.tid / 64.0f); ls[C.tid] = sinpif((float)C.tid / 64.0f); }
    __syncthreads();
    tr_matrix(C, I.w1g, FF, D, 0, FF, W1A, D, RmGU{0});   tr_matrix(C, I.w1u, FF, D, 0, FF, W1A, D, RmGU{128});
    tr_matrix(C, I.w2g, FF, D, 0, FF, W2A, D, RmGU{0});   tr_matrix(C, I.w2u, FF, D, 0, FF, W2A, D, RmGU{128});
    tr_matrix(C, I.w1d, D, FF, 0, D, W1D, FFP, RmOff{0}); tr_matrix(C, I.w2d, D, FF, 0, D, W2D, FFP, RmOff{0});
    tr_matrix(C, I.win, 7168, D, 0, AQ, WIN, D, RmOff{0});
    tr_matrix(C, I.win, 7168, D, AQ, AQ, WIN, D, RmOff{0});
    tr_matrix(C, I.win, 7168, D, 3 * AQ + FW, 2 * D, WIN, D, RmOff{2 * AQ - (3 * AQ + FW)});
    tr_matrix(C, I.win, 7168, D, 2 * AQ, AQ, WSW, D, RmOff{-2 * AQ});
    tr_matrix(C, I.wpa, D, FW, 0, D, WPA, FW, RmOff{0}); tr_matrix(C, I.wpf, D, FW, 0, D, WPF, FW, RmOff{0}); tr_matrix(C, I.wout, D, D, 0, D, WOUT, D, RmOff{0});
    const int gt = C.gw * 64 + C.lane, NGT = C.NGW * 64;
    for (int i = gt; i < 2 * 128 * (D / 8); i += NGT) { const int w = i / (128 * (D / 8)), r = (i / (D / 8)) % 128, c8 = i % (D / 8); const int row = 21 * 256 + 64 + (r & 63) + (r >> 6) * 128;
        *(v4u*)((w ? W2A : W1A) + (size_t)row * D + c8 * 8) = (v4u){0u, 0u, 0u, 0u}; }
    for (int i = gt; i < 2 * D * 8; i += NGT) { const int w = i / (D * 8), r = (i / 8) % D, c8 = i % 8; *(v4u*)((w ? W2D : W1D) + (size_t)r * FFP + FF + c8 * 8) = (v4u){0u, 0u, 0u, 0u}; }
    { LAS float* scr = (LAS float*)(C.lds + RING_OFF + C.wave * 16384);
      for (int it = C.gw; it < D * 4; it += C.NGW) { const int k = it >> 2, g = it & 3;
          const float* src = I.win + (size_t)k * 7168 + 3 * AQ + g * 128;
          scr[C.lane] = src[C.lane]; scr[C.lane + 64] = src[C.lane + 64];
          LDS_WAIT(); asm volatile("" ::: "memory");
          float ar0 = 0.f, ai0 = 0.f, ar1 = 0.f, ai1 = 0.f;
          for (int c = 0; c < 128; ++c) { const float w = scr[c]; const int i0 = (c * C.lane) & 127, i1 = (c * (C.lane + 64)) & 127;
              ar0 += w * lc[i0]; ai0 -= w * ls[i0]; ar1 += w * lc[i1]; ai1 -= w * ls[i1]; }
          WSW[(size_t)(AQ + g * 128 + C.lane) * D + k] = (bf16)f2bf(ar0);        WSW[(size_t)(AQ + g * 128 + C.lane + 64) * D + k] = (bf16)f2bf(ar1);
          WSW[(size_t)(AQ + 512 + g * 128 + C.lane) * D + k] = (bf16)f2bf(ai0);  WSW[(size_t)(AQ + 512 + g * 128 + C.lane + 64) * D + k] = (bf16)f2bf(ai1);
          LDS_WAIT(); asm volatile("" ::: "memory"); } }
    for (int i = gt; i < NIN; i += NGT) BIASN[i] = I.bin[i < 2 * AQ ? i : i + AQ + FW];
    for (int i = gt; i < NSW; i += NGT) {
        if (i < AQ) BIASW[i] = I.bin[2 * AQ + i];
        else { const int z = i - AQ, ri = z >> 9, g = (z >> 7) & 3, cp = z & 127; float a = 0.f;
            for (int c = 0; c < 128; ++c) { const int ix = (c * cp) & 127; a += I.bin[3 * AQ + g * 128 + c] * (ri ? -ls[ix] : lc[ix]); }
            BIASW[i] = a; } }
    for (int i = gt; i < NH * 129; i += NGT) { const int hd = i / 129, off = i % 129 - 64, dil = 1 << (2 * (hd >> 2)); TBL[i] = I.relb[t5_bucket(off * dil) * NH + hd]; }
    for (int i = gt; i < 8192; i += NGT) { COS[i] = cospif((float)i / 4096.0f); SIN[i] = sinpif((float)i / 4096.0f); }
    for (int m = C.gw; m < T; m += C.NGW) { const GAS f32x4* xr = (const GAS f32x4*)(I.x + (size_t)m * D) + C.lane; GAS unsigned long long* o8 = (GAS unsigned long long*)(XB + (size_t)m * D) + C.lane;
#pragma unroll
        for (int j = 0; j < 4; ++j) { const f32x4 v = xr[64 * j]; o8[64 * j] = (unsigned long long)pk2(v.x, v.y) | ((unsigned long long)pk2(v.z, v.w) << 32); } }
}

__device__ __forceinline__ void ln_pass(const Ctx& C, const float* v, float* outf, bf16* outb, const float* g, const float* b) {
    f32x4 gv[4], bv[4];
#pragma unroll
    for (int j = 0; j < 4; ++j) { gv[j] = *((const f32x4*)g + C.lane + 64 * j); bv[j] = *((const f32x4*)b + C.lane + 64 * j); }
    for (int m = C.gw; m < T; m += C.NGW) {
        const f32x4* xr = (const f32x4*)(v + (size_t)m * D) + C.lane;
        f32x4 x[4]; float s = 0.f;
#pragma unroll
        for (int j = 0; j < 4; ++j) { x[j] = xr[64 * j]; s += (x[j].x + x[j].y) + (x[j].z + x[j].w); }
        const float mean = wave_sum(s) * (1.f / D); float s2 = 0.f;
#pragma unroll
        for (int j = 0; j < 4; ++j) { x[j] = x[j] - mean; s2 += (x[j].x * x[j].x + x[j].y * x[j].y) + (x[j].z * x[j].z + x[j].w * x[j].w); }
        const float rstd = 1.f / sqrtf(wave_sum(s2) * (1.f / D) + LN_EPS);
#pragma unroll
        for (int j = 0; j < 4; ++j) { const f32x4 y = x[j] * rstd * gv[j] + bv[j];
            if (outf) *((f32x4*)(outf + (size_t)m * D) + C.lane + 64 * j) = y;
            if (outb) *((unsigned long long*)(outb + (size_t)m * D) + C.lane + 64 * j) = (unsigned long long)pk2(y.x, y.y) | ((unsigned long long)pk2(y.z, y.w) << 32); }
    }
}

__device__ __forceinline__ void attn_simple(const Ctx& C, bf16* QB, const bf16* KB, const bf16* VT, float* LSE, const float* TBL) {
    LAS float* slog = (LAS float*)(C.lds + RING_OFF + C.wave * 1024);
    for (int it = C.gw; it < T * NH; it += C.NGW) {
        const int tok = it / NH, hd = it % NH, g = hd >> 2, sh = 2 * g, L = SEQ >> sh, b = tok >> 13, s = tok & (SEQ - 1), r = s & ((1 << sh) - 1), m = s >> sh;
        const unsigned qw = *(const unsigned*)(QB + (size_t)tok * AQ + hd * HD + 2 * C.lane);
        const float q0 = pg8::bf_lo(qw), q1 = pg8::bf_hi(qw);
        float mx = -3.0e38f;
        for (int j = -64; j <= 64; ++j) { const int mk = m + j; float lg = -1e30f;
            if (mk >= 0 && mk < L) { const int kt = b * SEQ + (mk << sh) + r; const unsigned kw = *(const unsigned*)(KB + (size_t)kt * AQ + hd * HD + 2 * C.lane);
                lg = wave_sum(q0 * pg8::bf_lo(kw) + q1 * pg8::bf_hi(kw)) + TBL[hd * 129 + j + 64]; }
            if (C.lane == 0) slog[j + 64] = lg;
            mx = fmaxf(mx, lg); }
        LDS_WAIT(); asm volatile("" ::: "memory");
        float den = 0.f, o0 = 0.f, o1 = 0.f;
        const bf16* vrow = VT + ((size_t)(b * AQ + hd * HD + 2 * C.lane) * SEQ + r * L);
        for (int j = -64; j <= 64; ++j) { const int mk = m + j;
            if (mk >= 0 && mk < L) { const float p = __expf(slog[j + 64] - mx); den += p; const int pos = swap23(mk);
                o0 += p * bf2f(vrow[pos]); o1 += p * bf2f(vrow[SEQ + pos]); } }
        const float inv = 1.0f / den;
        *(unsigned*)(QB + (size_t)tok * AQ + hd * HD + 2 * C.lane) = pk2(o0 * inv, o1 * inv);
        if (C.lane == 0) LSE[(size_t)tok * NH + hd] = mx + logf(den);
        LDS_WAIT(); asm volatile("" ::: "memory");
    }
}
__device__ __forceinline__ void combine_simple(const Ctx& C, const bf16* QB, const float* LSE, bf16* ATT) {
    for (int tok = C.gw; tok < T; tok += C.NGW) {
#pragma unroll
        for (int h = 0; h < 4; ++h) {
            const float l0 = LSE[(size_t)tok * NH + h], l1 = LSE[(size_t)tok * NH + 4 + h], l2 = LSE[(size_t)tok * NH + 8 + h];
            const float mx = fmaxf(l0, fmaxf(l1, l2)); float w0 = __expf(l0 - mx), w1 = __expf(l1 - mx), w2 = __expf(l2 - mx); const float inv = 1.0f / (w0 + w1 + w2); w0 *= inv; w1 *= inv; w2 *= inv;
            const unsigned a = *(const unsigned*)(QB + (size_t)tok * AQ + h * HD + 2 * C.lane), bq = *(const unsigned*)(QB + (size_t)tok * AQ + (4 + h) * HD + 2 * C.lane), c = *(const unsigned*)(QB + (size_t)tok * AQ + (8 + h) * HD + 2 * C.lane);
            *(unsigned*)(ATT + (size_t)tok * FW + h * HD + 2 * C.lane) = pk2(w0 * pg8::bf_lo(a) + w1 * pg8::bf_lo(bq) + w2 * pg8::bf_lo(c), w0 * pg8::bf_hi(a) + w1 * pg8::bf_hi(bq) + w2 * pg8::bf_hi(c));
        }
    }
}
__device__ __forceinline__ void fft1_simple(const Ctx& C, const bf16* Z1, bf16* YP, const float* COS, const float* SIN) {
    for (int it = C.gw; it < FW * BATCH * 128; it += C.NGW) {
        const int s2 = it & 127, cb = it >> 7, k1 = C.lane;
        const bf16* z = Z1 + (size_t)it * 128;
        float yr = 0.f, yi = 0.f;
        for (int s1 = 0; s1 < 64; ++s1) { const float zr = bf2f(z[s1]), zi = bf2f(z[64 + s1]); const int ix = ((s1 * k1) & 63) * 128; const float c = COS[ix], s = SIN[ix];
            yr += zr * c + zi * s; yi += zi * c - zr * s; }
        const int ix2 = s2 * k1; const float c2 = COS[ix2], sn2 = SIN[ix2];
        const float pr = yr * c2 + yi * sn2, pi = yi * c2 - yr * sn2;
        bf16* o = YP + ((size_t)(cb * 64 + k1) * 2) * 128 + s2;
        o[0] = (bf16)f2bf(pr); o[128] = (bf16)f2bf(pi);
    }
}
__device__ __forceinline__ void fft2_simple(const Ctx& C, const bf16* YP, bf16* FOUR, const float* COS, const float* SIN) {
    for (int it = C.gw; it < BATCH * 64 * FW; it += C.NGW) {
        const int ch = it & 511, k1 = (it >> 9) & 63, b = it >> 15;
        const bf16* y = YP + ((size_t)((ch * 4 + b) * 64 + k1) * 2) * 128;
        float a0 = 0.f, a1 = 0.f;
        for (int s2 = 0; s2 < 128; ++s2) { const float yr = bf2f(y[s2]), yi = bf2f(y[128 + s2]); const int i0 = ((s2 * C.lane) & 127) * 64, i1 = ((s2 * (C.lane + 64)) & 127) * 64;
            a0 += yr * COS[i0] + yi * SIN[i0]; a1 += yr * COS[i1] + yi * SIN[i1]; }
        FOUR[(size_t)(b * SEQ + k1 + 64 * C.lane) * FW + ch] = (bf16)f2bf(a0 * (1.0f / 1024.0f));
        FOUR[(size_t)(b * SEQ + k1 + 64 * (C.lane + 64)) * FW + ch] = (bf16)f2bf(a1 * (1.0f / 1024.0f));
    }
}

struct Args { const float* in[19]; float* out; unsigned char* ws; int ph_lo, ph_hi, li, pad; };
__global__ void __launch_bounds__(NWAVES * 64, 2) mk_fwd(Args args) {
    extern __shared__ __attribute__((aligned(16))) unsigned char lds_raw[];
    Ctx C; C.lds = (LAS unsigned char*)lds_raw; C.tid = threadIdx.x; C.lane = C.tid & 63; C.wave = __builtin_amdgcn_readfirstlane(C.tid >> 6);
    C.G = gridDim.x; const int bx = blockIdx.x; const int vcu = (C.G % 8 == 0) ? (bx % 8) * (C.G / 8) + bx / 8 : bx;
    C.gw = vcu * NWAVES + C.wave; C.NGW = C.G * NWAVES;
    volatile LAS unsigned* MISC = (volatile LAS unsigned*)(C.lds + MISC_OFF);
    unsigned char* ws = args.ws;
    unsigned* ctl = (unsigned*)(ws + WS_CTL);
    for (int u = C.tid; u < (LDS_BYTES - LDSCTL_OFF) / 4; u += NWAVES * 64) ((LAS unsigned*)(C.lds + LDSCTL_OFF))[u] = 0u;
    __syncthreads();
    XcdBarrier bar; bar.bar = ctl + CW_BAR; bar.x = 0; bar.st = nullptr;
    if (N_LAUNCHES == 1) bar = xcd_barrier_post(ctl + CW_BAR, MISC + 8);
    Inputs I; { const float* const* p = args.in; I.x = p[0]; I.ln1g = p[1]; I.ln1b = p[2]; I.w1g = p[3]; I.w1u = p[4]; I.w1d = p[5]; I.win = p[6]; I.bin = p[7]; I.relb = p[8]; I.wpa = p[9]; I.wpf = p[10]; I.wout = p[11];
        I.ln2g = p[12]; I.ln2b = p[13]; I.w2g = p[14]; I.w2u = p[15]; I.w2d = p[16]; I.ln3g = p[17]; I.ln3b = p[18]; }
    float* OUT = args.out;
    bf16* W1A = (bf16*)(ws + WS_W1A); bf16* W1D = (bf16*)(ws + WS_W1D); bf16* W2A = (bf16*)(ws + WS_W2A); bf16* W2D = (bf16*)(ws + WS_W2D);
    bf16* WIN = (bf16*)(ws + WS_WIN); bf16* WSW = (bf16*)(ws + WS_WSW); bf16* WPA = (bf16*)(ws + WS_WPA); bf16* WOUT = (bf16*)(ws + WS_WOUT);
    float* BIASN = (float*)(ws + WS_TAB + TAB_BIASN); float* BIASW = (float*)(ws + WS_TAB + TAB_BIASW); float* TBL = (float*)(ws + WS_TAB + TAB_TBL);
    float* COS = (float*)(ws + WS_TAB + TAB_COS); float* SIN = (float*)(ws + WS_TAB + TAB_SIN); float* LSE = (float*)(ws + WS_TAB + TAB_LSE);
    bf16* XB = (bf16*)(ws + WS_XB); bf16* ACT = (bf16*)(ws + WS_ACT); bf16* QB = (bf16*)(ws + WS_QB); bf16* KB = (bf16*)(ws + WS_KB); bf16* VT = (bf16*)(ws + WS_VT);
    bf16* ATT = (bf16*)(ws + WS_ATT); bf16* FOUR = (bf16*)(ws + WS_FOUR); bf16* MRG = (bf16*)(ws + WS_MRG); bf16* YP = (bf16*)(ws + WS_YP); bf16* Z1 = (bf16*)(ws + WS_Z1);
    bf16* GATES = (bf16*)OUT;
    LAS unsigned char* ring = C.lds + RING_OFF;

    const int lo = args.ph_lo, hi = args.ph_hi;
#define IN(k) (lo <= (k) && (k) < hi)
#define SEAM(k) do { if (IN(k) && IN((k) + 1)) xcd_barrier(bar); } while (0)
    if (IN(0)) { p0_prologue(C, I, ws); VM_WAIT(); __syncthreads(); } SEAM(0);
    if (IN(1)) { SchedStd S{XB, W1A, D, D, T / 256, NUP / 256, C.G, bx}; EpiSwiGLU E{ACT}; pg8::gemm_phase(ring, D, S, E); } SEAM(1);
    if (IN(2)) { SchedStd S{ACT, W1D, FFP, FFP, T / 256, D / 256, C.G, bx}; EpiDown E{I.x, OUT}; pg8::gemm_phase(ring, FFP, S, E); } SEAM(2);
    if (IN(3)) { ln_pass(C, OUT, nullptr, XB, I.ln1g, I.ln1b); } SEAM(3);
    if (IN(4)) { { SchedStd S{XB, WIN, D, D, T / 256, NIN / 256, C.G, bx}; EpiInproj E{QB, KB, GATES, BIASN}; pg8::gemm_phase(ring, D, S, E); }
                 { SchedSw S{WSW, XB, C.G, bx}; EpiSw E{VT, Z1, BIASW}; pg8::gemm_phase(ring, D, S, E); } } SEAM(4);
    if (IN(5)) { attn_simple(C, QB, KB, VT, LSE, TBL); } SEAM(5);
    if (IN(6)) { combine_simple(C, QB, LSE, ATT); fft1_simple(C, Z1, YP, COS, SIN); } SEAM(6);
    if (IN(7)) { fft2_simple(C, YP, FOUR, COS, SIN); } SEAM(7);
    if (IN(8)) { SchedProj S{ATT, WPA, C.G, bx}; EpiProj E{GATES, MRG}; pg8::gemm_phase(ring, FW, S, E); } SEAM(8);
    if (IN(9)) { SchedStd S{MRG, WOUT, D, D, T / 256, D / 256, C.G, bx}; EpiWout E{XB, OUT}; pg8::gemm_phase(ring, D, S, E); } SEAM(9);
    if (IN(10)) { ln_pass(C, OUT, OUT, XB, I.ln2g, I.ln2b); } SEAM(10);
    if (IN(11)) { SchedStd S{XB, W2A, D, D, T / 256, NUP / 256, C.G, bx}; EpiSwiGLU E{ACT}; pg8::gemm_phase(ring, D, S, E); } SEAM(11);
    if (IN(12)) { SchedStd S{ACT, W2D, FFP, FFP, T / 256, D / 256, C.G, bx}; EpiDown E{OUT, OUT}; pg8::gemm_phase(ring, FFP, S, E); } SEAM(12);
    if (IN(13)) { ln_pass(C, OUT, OUT, nullptr, I.ln3g, I.ln3b); }
#undef IN
#undef SEAM
}

extern "C" void kernel_launch(void* const* d_in, const int* in_sizes, int n_in, void* d_out, int out_size, void* d_ws, size_t ws_size, hipStream_t stream) {
    static int grid = 0;
    if (grid == 0) {
        if (n_in != 19 || out_size != T * D || ws_size < WS_END) { fprintf(stderr, "kernel_launch: unexpected shapes (n_in %d, out %d, ws %zu); nothing launched\n", n_in, out_size, ws_size); grid = -1; return; }
        int dev = 0, cus = 0, per_cu = 0;
        if (hipGetDevice(&dev) != hipSuccess || hipDeviceGetAttribute(&cus, hipDeviceAttributeMultiprocessorCount, dev) != hipSuccess) { grid = -1; return; }
        if (hipFuncSetAttribute((const void*)mk_fwd, hipFuncAttributeMaxDynamicSharedMemorySize, LDS_BYTES) != hipSuccess) { fprintf(stderr, "kernel_launch: hipFuncSetAttribute failed\n"); grid = -1; return; }
        if (hipOccupancyMaxActiveBlocksPerMultiprocessor(&per_cu, (const void*)mk_fwd, NWAVES * 64, LDS_BYTES) != hipSuccess || per_cu < 1) fprintf(stderr, "kernel_launch: occupancy query reports %d\n", per_cu);
        (void)hipGetLastError();
        grid = cus;
    }
    if (grid < 0) return;
    if (hipMemsetAsync((char*)d_ws + WS_CTL, 0, CTL_ZERO_BYTES, stream) != hipSuccess) return;
    Args a{};
    for (int i = 0; i < 19; ++i) a.in[i] = (const float*)d_in[i];
    a.out = (float*)d_out; a.ws = (unsigned char*)d_ws;
    if (N_LAUNCHES == 1) { a.ph_lo = 0; a.ph_hi = N_PHASES; a.li = 0; hipLaunchKernelGGL(mk_fwd, dim3(grid), dim3(NWAVES * 64), LDS_BYTES, stream, a); }
    else for (int li = 0; li < N_PHASES; ++li) { a.ph_lo = li; a.ph_hi = li + 1; a.li = li; hipLaunchKernelGGL(mk_fwd, dim3(grid), dim3(NWAVES * 64), LDS_BYTES, stream, a); }
}
```

```cpp
#include <hip/hip_runtime.h>
#include <cstdio>
#include <cstdint>

#ifndef MK_N_LAUNCHES
#define MK_N_LAUNCHES 1
#endif

namespace pg8 {
#define PG8_LAS __attribute__((address_space(3)))
typedef unsigned short bf16_t;
typedef short bf16x8 __attribute__((ext_vector_type(8)));
typedef float f32x4 __attribute__((ext_vector_type(4)));
typedef float f32x2 __attribute__((ext_vector_type(2)));
typedef unsigned u32x4 __attribute__((ext_vector_type(4)));
typedef unsigned u32x2 __attribute__((ext_vector_type(2)));
constexpr int BM = 256, BK = 64, HALF = 128, HTB = HALF * BK * 2, STAGE_BYTES = 8 * HTB, NXCD = 8, WGM = 8;

__host__ __device__ __forceinline__ int lds_byte(int r, int c) { const int st = (r >> 4) * 2 + (c >> 5), rr = r & 15, cc = c & 31, ob = rr * 64 + cc * 2; return st * 1024 + (ob ^ (((ob >> 9) & 1) << 5)); }
__host__ __device__ __forceinline__ void stage_rc(int b, int& R, int& C) { const int st = b / 1024, sb = b % 1024, swz = sb ^ (((sb >> 9) & 1) << 5); R = (st >> 1) * 16 + swz / 64; C = (st & 1) * 32 + (swz % 64) / 2; }
__host__ __device__ __forceinline__ int perm32(int rho) { const int n = rho >> 4, i = rho & 15; return 8 * (i >> 2) + 4 * n + (i & 3); }

struct Unit { int pm, pn, kind; };

__device__ __forceinline__ void tile_of(int L, int nM, int nN, int& pm, int& pn) {
    const int nwg = nM * nN; int wgid = L;
    { const int q = nwg / NXCD, r = nwg % NXCD, xcd = wgid % NXCD, off = wgid / NXCD; wgid = (xcd < r ? xcd * (q + 1) : r * (q + 1) + (xcd - r) * q) + off; }
    const int nig = WGM * nN, gid = wgid / nig, fm = gid * WGM, gsz = (nM - fm) < WGM ? (nM - fm) : WGM;
    pm = fm + ((wgid % nig) % gsz); pn = (wgid % nig) / gsz;
}

__device__ __forceinline__ unsigned cvt_pk_bf16(float lo, float hi) { unsigned r; asm volatile("v_cvt_pk_bf16_f32 %0, %1, %2" : "=v"(r) : "v"(lo), "v"(hi)); return r; }
__device__ __forceinline__ float bf_lo(unsigned w) { return __uint_as_float(w << 16); }
__device__ __forceinline__ float bf_hi(unsigned w) { return __uint_as_float(w & 0xffff0000u); }

template <class Epi, class Sched>
__device__ __forceinline__ void gemm_phase(PG8_LAS unsigned char* lds, const int K, const Sched& S, const Epi& E) {
    const int tid = threadIdx.x, wid = __builtin_amdgcn_readfirstlane(tid >> 6), lane = tid & 63, wr = wid >> 2, wc = wid & 3, fr = lane & 15, fq = lane >> 4;
    const int nt = K / BK;
    const int lda = S.lda(), ldb = S.ldb();
    unsigned voffA[2], cvB[2], nvB[2];
    Unit cur, nxt; int ui = 0;
    if (!S.next(0, cur)) return;
#define PG8_VB(dst, u) do { _Pragma("unroll") for (int _i = 0; _i < 2; ++_i) { int R_, C_; stage_rc(tid * 16 + _i * 8192, R_, C_); const int Rb_ = Epi::PERM ? ((R_ & ~31) + perm32(R_ & 31)) : R_; \
        if constexpr (Sched::GATHER) dst[_i] = (unsigned)(S.btok(u, Rb_) * ldb + C_) * 2u; else dst[_i] = (unsigned)(Rb_ * ldb + C_) * 2u; } } while (0)
#pragma unroll
    for (int i = 0; i < 2; ++i) { int R, C; stage_rc(tid * 16 + i * 8192, R, C); voffA[i] = (unsigned)(R * lda + C) * 2u; }
    PG8_VB(cvB, cur);
    const size_t kstep = (size_t)(BK * 2);
    const size_t hstepA = (size_t)HALF * lda * 2;
    size_t chB, nhB;
    if constexpr (Sched::GATHER) chB = S.bhalf(cur); else chB = (size_t)HALF * ldb * 2;
    nhB = chB; nvB[0] = cvB[0]; nvB[1] = cvB[1];
    const unsigned ldsw = (unsigned)wid * 1024u;
    const int aoff = lds_byte(wr * 64 + fr, fq * 8), boff = lds_byte(wc * 32 + fr, fq * 8);
#define PG8_SA(b, h) (((b) * 2 + (h)) * HTB)
#define PG8_SB(b, h) ((4 + (b) * 2 + (h)) * HTB)
#define PG8_STAGE(bufoff, gbase, v0, v1) do { \
        __builtin_amdgcn_global_load_lds((const unsigned*)((const char*)(gbase) + (v0)), (PG8_LAS unsigned*)(lds + (bufoff) + ldsw), 16, 0, 0); \
        __builtin_amdgcn_global_load_lds((const unsigned*)((const char*)(gbase) + (v1)), (PG8_LAS unsigned*)(lds + (bufoff) + ldsw + 8192), 16, 0, 0); } while (0)
#define PG8_STA(bufoff, gbase) PG8_STAGE(bufoff, gbase, voffA[0], voffA[1])
#define PG8_LDA(dst, b, h) do { _Pragma("unroll") for (int m = 0; m < 4; ++m) _Pragma("unroll") for (int k = 0; k < 2; ++k) dst[m][k] = *(const PG8_LAS bf16x8*)(lds + PG8_SA(b, h) + aoff + m * 2048 + k * 1024); } while (0)
#define PG8_LDB(dst, b, h) do { _Pragma("unroll") for (int n = 0; n < 2; ++n) _Pragma("unroll") for (int k = 0; k < 2; ++k) dst[n][k] = *(const PG8_LAS bf16x8*)(lds + PG8_SB(b, h) + boff + n * 2048 + k * 1024); } while (0)
#define PG8_MMA(ai, bj, At, Bt) do { __builtin_amdgcn_s_setprio(1); _Pragma("unroll") for (int m = 0; m < 4; ++m) _Pragma("unroll") for (int n = 0; n < 2; ++n) _Pragma("unroll") for (int k = 0; k < 2; ++k) \
        acc[ai][bj][m][n] = __builtin_amdgcn_mfma_f32_16x16x32_bf16(Bt[n][k], At[m][k], acc[ai][bj][m][n], 0, 0, 0); __builtin_amdgcn_s_setprio(0); } while (0)
#define PG8_WAIT_V(n) asm volatile("s_waitcnt vmcnt(" #n ")" ::: "memory")
#define PG8_WAIT_L(n) asm volatile("s_waitcnt lgkmcnt(" #n ")" ::: "memory")
#define PG8_BAR __builtin_amdgcn_s_barrier()
#define PG8_SCHED __builtin_amdgcn_sched_barrier(0)
    f32x4 acc[2][2][4][2];
#pragma unroll
    for (int a = 0; a < 2; ++a)
#pragma unroll
        for (int b = 0; b < 2; ++b)
#pragma unroll
            for (int m = 0; m < 4; ++m)
#pragma unroll
                for (int n = 0; n < 2; ++n) acc[a][b][m][n] = (f32x4){0.f, 0.f, 0.f, 0.f};
    bf16x8 At[4][2], B0[2][2], B1[2][2];
    const char* cA = S.abase(cur); const char* cB = S.bbase(cur);
    PG8_STAGE(PG8_SB(0, 0), cB, cvB[0], cvB[1]); PG8_STAGE(PG8_SB(0, 1), cB + chB, cvB[0], cvB[1]); PG8_STA(PG8_SA(0, 0), cA); PG8_STA(PG8_SA(0, 1), cA + hstepA);
    if (wr == 1) PG8_BAR;
    PG8_WAIT_V(2); PG8_BAR;
    PG8_STAGE(PG8_SB(1, 0), cB + kstep, cvB[0], cvB[1]); PG8_STA(PG8_SA(1, 0), cA + kstep); PG8_STAGE(PG8_SB(1, 1), cB + chB + kstep, cvB[0], cvB[1]);
    PG8_WAIT_V(6); PG8_BAR;
    for (;;) {
        const bool has_next = S.next(ui + 1, nxt);
        const char* nA = has_next ? S.abase(nxt) : cA; const char* nB = has_next ? S.bbase(nxt) : cB;
        if constexpr (Sched::GATHER) { if (has_next) { PG8_VB(nvB, nxt); nhB = S.bhalf(nxt); } else { nvB[0] = cvB[0]; nvB[1] = cvB[1]; nhB = chB; } }
        for (int t = 0; t < nt; t += 2) {
            const bool last = (t == nt - 2);
            const char* a1 = cA + (size_t)(t + 1) * kstep;
            const char* a2 = last ? nA : cA + (size_t)(t + 2) * kstep; const char* b2 = last ? nB : cB + (size_t)(t + 2) * kstep;
            const char* a3 = a2 + kstep; const char* b3 = b2 + kstep;
            unsigned v20, v21; size_t h2;
            if constexpr (Sched::GATHER) { v20 = last ? nvB[0] : cvB[0]; v21 = last ? nvB[1] : cvB[1]; h2 = last ? nhB : chB; } else { v20 = cvB[0]; v21 = cvB[1]; h2 = chB; }
            PG8_LDB(B0, 0, 0); PG8_LDB(B1, 0, 1); PG8_SCHED; PG8_LDA(At, 0, 0); PG8_STA(PG8_SA(1, 1), a1 + hstepA);
            PG8_WAIT_V(8); PG8_WAIT_L(0); PG8_BAR; PG8_MMA(0, 0, At, B0); PG8_MMA(0, 1, At, B1); PG8_BAR; PG8_SCHED;
            PG8_LDA(At, 0, 1); PG8_STAGE(PG8_SB(0, 0), b2, v20, v21); PG8_STAGE(PG8_SB(0, 1), b2 + h2, v20, v21); PG8_STA(PG8_SA(0, 0), a2);
            PG8_WAIT_V(8); PG8_WAIT_L(0); PG8_BAR; PG8_MMA(1, 0, At, B0); PG8_MMA(1, 1, At, B1); PG8_BAR; PG8_SCHED;
            PG8_LDB(B0, 1, 0); PG8_LDB(B1, 1, 1); PG8_SCHED; PG8_LDA(At, 1, 0); PG8_STA(PG8_SA(0, 1), a2 + hstepA);
            PG8_WAIT_V(8); PG8_WAIT_L(0); PG8_BAR; PG8_MMA(0, 0, At, B0); PG8_MMA(0, 1, At, B1); PG8_BAR; PG8_SCHED;
            PG8_LDA(At, 1, 1); PG8_STAGE(PG8_SB(1, 0), b3, v20, v21); PG8_STAGE(PG8_SB(1, 1), b3 + h2, v20, v21); PG8_STA(PG8_SA(1, 0), a3);
            PG8_WAIT_V(8); PG8_WAIT_L(0); PG8_BAR; PG8_MMA(1, 0, At, B0); PG8_MMA(1, 1, At, B1); PG8_BAR; PG8_SCHED;
        }
        if (wr == 0) PG8_BAR;
        E(acc, cur, wr, wc, fr, fq);
        if (!has_next) break;
#pragma unroll
        for (int a = 0; a < 2; ++a)
#pragma unroll
            for (int b = 0; b < 2; ++b)
#pragma unroll
                for (int m = 0; m < 4; ++m)
#pragma unroll
                    for (int n = 0; n < 2; ++n) acc[a][b][m][n] = (f32x4){0.f, 0.f, 0.f, 0.f};
        cur = nxt; cA = nA; cB = nB; ++ui;
        if constexpr (Sched::GATHER) { cvB[0] = nvB[0]; cvB[1] = nvB[1]; chB = nhB; }
        if (wr == 1) PG8_BAR;
    }
    PG8_WAIT_V(0);
    PG8_BAR;
#undef PG8_VB
#undef PG8_SA
#undef PG8_SB
#undef PG8_STAGE
#undef PG8_STA
#undef PG8_LDA
#undef PG8_LDB
#undef PG8_MMA
#undef PG8_WAIT_V
#undef PG8_WAIT_L
#undef PG8_BAR
#undef PG8_SCHED
}
}

constexpr int NWAVES = 8;
constexpr int N_LAUNCHES = MK_N_LAUNCHES;
constexpr int N_PHASES = 14;
constexpr int BATCH = 4, SEQ = 8192, T = BATCH * SEQ, D = 1024, FF = 2752, FFP = 2816, NUP = 2 * FFP;
constexpr int NH = 12, HD = 128, AQ = NH * HD;
constexpr int FW = 512;
constexpr int NIN = 2 * AQ + 2 * D;
constexpr int NSW = AQ + 2 * FW;
constexpr float LN_EPS = 1e-5f;
constexpr float ALPHA = 1.18920711500272f;
constexpr float QSCALE = 0.08838834764831845f * 1.4426950408889634f;
constexpr float LOG2E = 1.4426950408889634f, LN2 = 0.6931471805599453f;

constexpr size_t MiB = 1u << 20;
constexpr size_t WS_CTL = 0, CTL_ZERO_BYTES = 1 * MiB;
constexpr size_t WS_W1A = 1 * MiB, WS_W1D = 12 * MiB, WS_W2A = 18 * MiB, WS_W2D = 29 * MiB, WS_WIN = 35 * MiB, WS_WSW = 45 * MiB, WS_WPA = 50 * MiB, WS_WPF = 51 * MiB, WS_WOUT = 52 * MiB;
constexpr size_t WS_TAB = 54 * MiB;
constexpr size_t TAB_BIASN = 0, TAB_BIASW = 32768, TAB_TBL = 65536, TAB_COS = 81920, TAB_SIN = 81920 + 32768, TAB_LSE = 1 * MiB;
constexpr size_t WS_XB = 58 * MiB;
constexpr size_t WS_BIG = 122 * MiB;
constexpr size_t WS_ACT = WS_BIG;
constexpr size_t WS_QB = WS_BIG, WS_KB = WS_BIG + 96 * MiB, WS_VT = WS_BIG + 192 * MiB;
constexpr size_t WS_ATT = WS_KB, WS_FOUR = WS_KB + 32 * MiB, WS_MRG = WS_KB + 64 * MiB, WS_YP = WS_KB + 128 * MiB;
constexpr size_t WS_Z1 = 410 * MiB, WS_END = 474 * MiB;
static_assert(WS_YP + 64 * MiB <= WS_Z1 && WS_MRG + 64 * MiB <= WS_YP && WS_ACT + (size_t)T * FFP * 2 <= WS_Z1, "d_ws map");
constexpr int CW_BAR = 4096;

constexpr int RING_OFF = 0, RING_BYTES = 131072;
constexpr int LDSCTL_OFF = RING_BYTES, MISC_OFF = LDSCTL_OFF + 320, LTAB_OFF = RING_BYTES + 1024;
constexpr int LDS_BYTES = 147456;

#define GAS __attribute__((address_space(1)))
#define LAS __attribute__((address_space(3)))
typedef unsigned short bf16;
typedef unsigned v4u __attribute__((ext_vector_type(4)));
typedef unsigned v2u __attribute__((ext_vector_type(2)));
typedef float f32x4 __attribute__((ext_vector_type(4)));
#define RLX_AGENT __ATOMIC_RELAXED, __HIP_MEMORY_SCOPE_AGENT
#define LDS_WAIT() asm volatile("s_waitcnt lgkmcnt(0)" ::: "memory")
#define VM_WAIT() asm volatile("s_waitcnt vmcnt(0)" ::: "memory")
__device__ __forceinline__ unsigned f2bf(float f) { unsigned u = __builtin_bit_cast(unsigned, f); return (u + 0x7fffu + ((u >> 16) & 1u)) >> 16; }
__device__ __forceinline__ unsigned pk2(float lo, float hi) { return f2bf(lo) | (f2bf(hi) << 16); }
__device__ __forceinline__ float bf2f(unsigned short h) { return __uint_as_float(((unsigned)h) << 16); }

#define XB_TMO      128
#define XB_XCNT(j)  (256  + 64 * (j))
#define XB_XSUB(j)  (1280 + 64 * (j))
#define XB_XGEN(j)  (2304 + 64 * (j))
#define XB_TOP      3328
#define XB_TOPGEN   3392
#define XCD_BAR_WORDS 3456
#define XB_SPIN_CAP (1u << 18)
__device__ __forceinline__ unsigned xb_ld(unsigned* p)              { return __hip_atomic_load(p, __ATOMIC_RELAXED, __HIP_MEMORY_SCOPE_AGENT); }
__device__ __forceinline__ unsigned xb_add(unsigned* p, unsigned v) { return __hip_atomic_fetch_add(p, v, __ATOMIC_RELAXED, __HIP_MEMORY_SCOPE_AGENT); }
__device__ __forceinline__ unsigned xb_xcc_id() { return (unsigned)__builtin_amdgcn_s_getreg((3 << 11) | 20) & 0xFu; }
#define XB_SPIN(cond, bar) do { unsigned _sp = 0; while (cond) { __builtin_amdgcn_s_sleep(1); \
    if ((++_sp & 255u) == 0u) { if (xb_ld(&(bar)[XB_TMO])) break; if (_sp > XB_SPIN_CAP) { atomicAdd(&(bar)[XB_TMO], 1u); break; } } } } while (0)
struct XcdBarrier { unsigned* bar; unsigned x; volatile LAS unsigned* st; };
__device__ __forceinline__ XcdBarrier xcd_barrier_post(unsigned* bar, volatile LAS unsigned* st) {
    XcdBarrier b; b.bar = bar; b.x = xb_xcc_id(); b.st = st;
    if (threadIdx.x == 0) (void)xb_add(&bar[XB_XCNT(b.x)], 1u);
    return b;
}
__device__ __forceinline__ void xcd_barrier_complete(unsigned* bar, unsigned x, unsigned& nloc, unsigned& nx) {
    const unsigned G = gridDim.x * gridDim.y * gridDim.z;
    unsigned sum, cnt, mine, sp = 0u;
    for (;;) {
        sum = 0u; cnt = 0u; mine = 0u;
#pragma unroll
        for (unsigned j = 0; j < 16; ++j) { const unsigned c = xb_ld(&bar[XB_XCNT(j)]); sum += c; cnt += (c > 0u) ? 1u : 0u; mine = (j == x) ? c : mine; }
        if (sum == G) break;
        __builtin_amdgcn_s_sleep(1);
        if ((++sp & 255u) == 0u) { if (xb_ld(&bar[XB_TMO])) break; if (sp > XB_SPIN_CAP) { atomicAdd(&bar[XB_TMO], 1u); break; } }
    }
    nloc = mine > 0u ? mine : 1u; nx = cnt > 0u ? cnt : 1u;
}
__device__ __forceinline__ void xcd_barrier(const XcdBarrier& b) {
    asm volatile("s_waitcnt vmcnt(0)" ::: "memory");
    __syncthreads();
    if (threadIdx.x == 0) {
        unsigned* bar = b.bar;
        __builtin_amdgcn_s_waitcnt(0);
        unsigned nloc = b.st[0], nx = b.st[1];
        if (nloc == 0u) { xcd_barrier_complete(bar, b.x, nloc, nx); b.st[0] = nloc; b.st[1] = nx; }
        const unsigned old = xb_add(&bar[XB_XSUB(b.x)], 1u);
        const unsigned gen = old / nloc;
        if (old + 1u == (gen + 1u) * nloc) {
            __builtin_amdgcn_fence(__ATOMIC_RELEASE, "agent");
            asm volatile("s_waitcnt vmcnt(0)" ::: "memory");
            const unsigned og = xb_add(&bar[XB_TOP], 1u);
            const unsigned tg = og / nx;
            if (og + 1u == (tg + 1u) * nx) xb_add(&bar[XB_TOPGEN], 1u);
            else XB_SPIN(xb_ld(&bar[XB_TOPGEN]) == tg, bar);
            __builtin_amdgcn_fence(__ATOMIC_ACQUIRE, "agent");
            xb_add(&bar[XB_XGEN(b.x)], 1u);
            asm volatile("s_waitcnt vmcnt(0)" ::: "memory");
        } else {
            XB_SPIN(xb_ld(&bar[XB_XGEN(b.x)]) == gen, bar);
            __builtin_amdgcn_fence(__ATOMIC_ACQUIRE, "agent");
            asm volatile("s_waitcnt vmcnt(0)" ::: "memory");
        }
    }
    __syncthreads();
}

struct SchedStd {
    static constexpr bool GATHER = false;
    const bf16* A; const bf16* Bt; int lda_, ldb_, nM, nN, G, c;
    __device__ __forceinline__ int lda() const { return lda_; }
    __device__ __forceinline__ int ldb() const { return ldb_; }
    __device__ __forceinline__ bool next(int i, pg8::Unit& u) const { const long L = (long)i * G + c; if (L >= (long)nM * nN) return false; pg8::tile_of((int)L, nM, nN, u.pm, u.pn); u.kind = 0; return true; }
    __device__ __forceinline__ const char* abase(const pg8::Unit& u) const { return (const char*)A + (size_t)u.pm * 256 * lda_ * 2; }
    __device__ __forceinline__ const char* bbase(const pg8::Unit& u) const { return (const char*)Bt + (size_t)u.pn * 256 * ldb_ * 2; }
    __device__ __forceinline__ int btok(const pg8::Unit&, int j) const { return j; }
    __device__ __forceinline__ size_t bhalf(const pg8::Unit&) const { return (size_t)128 * ldb_ * 2; }
};
struct SchedProj {
    static constexpr bool GATHER = false;
    const bf16* ATT; const bf16* WPA; int G, c;
    __device__ __forceinline__ int lda() const { return FW; }
    __device__ __forceinline__ int ldb() const { return FW; }
    __device__ __forceinline__ bool next(int i, pg8::Unit& u) const { const long L = (long)(i >> 1) * G + c; if (L >= (long)(T / 256) * (D / 256)) return false; pg8::tile_of((int)L, T / 256, D / 256, u.pm, u.pn); u.kind = i & 1; return true; }
    __device__ __forceinline__ const char* abase(const pg8::Unit& u) const { return (const char*)ATT + ((size_t)u.kind * T * FW + (size_t)u.pm * 256 * FW) * 2; }
    __device__ __forceinline__ const char* bbase(const pg8::Unit& u) const { return (const char*)WPA + ((size_t)u.kind * D * FW + (size_t)u.pn * 256 * FW) * 2; }
    __device__ __forceinline__ int btok(const pg8::Unit&, int j) const { return j; }
    __device__ __forceinline__ size_t bhalf(const pg8::Unit&) const { return (size_t)128 * FW * 2; }
};
__device__ __forceinline__ int swap23(int j) { return (j & ~12) | ((j & 4) << 1) | ((j & 8) >> 1); }
struct SchedSw {
    static constexpr bool GATHER = true;
    const bf16* WSW; const bf16* H1; int G, c;
    __device__ __forceinline__ int lda() const { return D; }
    __device__ __forceinline__ int ldb() const { return D; }
    __device__ __forceinline__ bool next(int i, pg8::Unit& u) const { const long L = (long)i * G + c; if (L >= (long)(NSW / 256) * (T / 256)) return false; pg8::tile_of((int)L, NSW / 256, T / 256, u.pm, u.pn); u.kind = 0; return true; }
    __device__ __forceinline__ const char* abase(const pg8::Unit& u) const { return (const char*)WSW + (size_t)u.pm * 256 * D * 2; }
    __device__ __forceinline__ const char* bbase(const pg8::Unit& u) const {
        const int b = u.pn >> 5, nb0 = (u.pn & 31) * 256; int tok0;
        if (u.pm < 6) { const int sh = 2 * (u.pm >> 1), L = SEQ >> sh, r = nb0 / L, mp0 = nb0 & (L - 1); tok0 = b * SEQ + (mp0 << sh) + r; }
        else tok0 = b * SEQ + (u.pn & 31) * 4;
        return (const char*)H1 + (size_t)tok0 * D * 2;
    }
    __device__ __forceinline__ int btok(const pg8::Unit& u, int j) const { return (u.pm < 6) ? (swap23(j) << (2 * (u.pm >> 1))) : (128 * (j & 63) + (j >> 6)); }
    __device__ __forceinline__ size_t bhalf(const pg8::Unit& u) const { return (u.pm < 6) ? ((size_t)(128 << (2 * (u.pm >> 1))) * D * 2) : ((size_t)2 * D * 2); }
};

using pg8::f32x2;
__device__ __forceinline__ float sigmoidf_(float v) { return __builtin_amdgcn_rcpf(1.0f + __builtin_amdgcn_exp2f(-1.4426950408889634f * v)); }
struct EpiSwiGLU {
    static constexpr bool PERM = true;
    bf16* O;
    __device__ __forceinline__ void operator()(const f32x4 (&acc)[2][2][4][2], const pg8::Unit& u, int wr, int wc, int fr, int fq) const {
        const int row0 = u.pm * 256 + wr * 64 + fr, col0 = u.pn * 128 + wc * 32 + 8 * fq;
#pragma unroll
        for (int ai = 0; ai < 2; ++ai)
#pragma unroll
            for (int m = 0; m < 4; ++m) {
                float o[8];
#pragma unroll
                for (int n = 0; n < 2; ++n)
#pragma unroll
                    for (int j = 0; j < 4; ++j) { const float g = acc[ai][0][m][n][j], up = acc[ai][1][m][n][j]; o[4 * n + j] = g * sigmoidf_(g) * up; }
                v4u w; w.x = pg8::cvt_pk_bf16(o[0], o[1]); w.y = pg8::cvt_pk_bf16(o[2], o[3]); w.z = pg8::cvt_pk_bf16(o[4], o[5]); w.w = pg8::cvt_pk_bf16(o[6], o[7]);
                *(v4u*)(O + (size_t)(row0 + ai * 128 + m * 16) * FFP + col0) = w; }
    }
};
struct EpiInproj {
    static constexpr bool PERM = true;
    bf16* QB; bf16* KB; bf16* GATES; const float* bias;
    __device__ __forceinline__ void operator()(const f32x4 (&acc)[2][2][4][2], const pg8::Unit& u, int wr, int wc, int fr, int fq) const {
        const int row0 = u.pm * 256 + wr * 64 + fr, cw = wc * 32 + 8 * fq;
        bf16* base; int ldc, mode;
        if (u.pn < 6) { base = QB + u.pn * 256; ldc = AQ; mode = 0; } else if (u.pn < 12) { base = KB + (u.pn - 6) * 256; ldc = AQ; mode = 1; } else { base = GATES + (u.pn - 12) * 256; ldc = 2 * D; mode = 2; }
        f32x4 bv[2][2];
#pragma unroll
        for (int bj = 0; bj < 2; ++bj)
#pragma unroll
            for (int n = 0; n < 2; ++n) bv[bj][n] = *(const f32x4*)(bias + u.pn * 256 + bj * 128 + cw + 4 * n);
#pragma unroll
        for (int ai = 0; ai < 2; ++ai)
#pragma unroll
            for (int m = 0; m < 4; ++m) { bf16* rowp = base + (size_t)(row0 + ai * 128 + m * 16) * ldc + cw;
#pragma unroll
                for (int bj = 0; bj < 2; ++bj) { f32x4 v0 = acc[ai][bj][m][0] + bv[bj][0], v1 = acc[ai][bj][m][1] + bv[bj][1];
                    if (mode == 0) { v0 = v0 * QSCALE; v1 = v1 * QSCALE; }
                    if (mode == 2) {
#pragma unroll
                        for (int j = 0; j < 4; ++j) { v0[j] = sigmoidf_(v0[j]); v1[j] = sigmoidf_(v1[j]); } }
                    v4u w; w.x = pg8::cvt_pk_bf16(v0[0], v0[1]); w.y = pg8::cvt_pk_bf16(v0[2], v0[3]); w.z = pg8::cvt_pk_bf16(v1[0], v1[1]); w.w = pg8::cvt_pk_bf16(v1[2], v1[3]);
                    *(v4u*)(rowp + bj * 128) = w; } }
    }
};
struct EpiSw {
    static constexpr bool PERM = true;
    bf16* VT; bf16* Z1; const float* bias;
    __device__ __forceinline__ void operator()(const f32x4 (&acc)[2][2][4][2], const pg8::Unit& u, int wr, int wc, int fr, int fq) const {
        const int r0 = u.pm * 256 + wr * 64 + fr, n0 = u.pn * 256 + wc * 32 + 8 * fq;
#pragma unroll
        for (int ai = 0; ai < 2; ++ai)
#pragma unroll
            for (int m = 0; m < 4; ++m) { const int R = r0 + ai * 128 + m * 16; const float bs = bias[R];
#pragma unroll
                for (int bj = 0; bj < 2; ++bj) { const int n = n0 + bj * 128; const f32x4 v0 = acc[ai][bj][m][0] + bs, v1 = acc[ai][bj][m][1] + bs;
                    v4u w; w.x = pg8::cvt_pk_bf16(v0[0], v0[1]); w.y = pg8::cvt_pk_bf16(v0[2], v0[3]); w.z = pg8::cvt_pk_bf16(v1[0], v1[1]); w.w = pg8::cvt_pk_bf16(v1[2], v1[3]);
                    bf16* p;
                    if (u.pm < 6) p = VT + ((size_t)((n >> 13) * AQ + R) * SEQ + (n & (SEQ - 1)));
                    else { const int zr = R - AQ, ri = zr >> 9, ch = zr & 511, b = n >> 13, s2 = (n >> 6) & 127, s1 = n & 63; p = Z1 + ((((size_t)(ch * 4 + b) * 128 + s2) * 2 + ri) * 64 + s1); }
                    *(v4u*)p = w; } }
    }
};
struct EpiDown {
    static constexpr bool PERM = false;
    const float* res; float* out;
    __device__ __forceinline__ void operator()(const f32x4 (&acc)[2][2][4][2], const pg8::Unit& u, int wr, int wc, int fr, int fq) const {
        const int row0 = u.pm * 256 + wr * 64 + fr, col0 = u.pn * 256 + wc * 32 + 4 * fq;
#pragma unroll
        for (int ai = 0; ai < 2; ++ai)
#pragma unroll
            for (int m = 0; m < 4; ++m) { const size_t off = (size_t)(row0 + ai * 128 + m * 16) * D + col0;
#pragma unroll
                for (int bj = 0; bj < 2; ++bj)
#pragma unroll
                    for (int n = 0; n < 2; ++n) { const f32x4 r = *(const f32x4*)(res + off + bj * 128 + n * 16); *(f32x4*)(out + off + bj * 128 + n * 16) = r * ALPHA + acc[ai][bj][m][n] * 0.5f; } }
    }
};
struct EpiWout {
    static constexpr bool PERM = false;
    const bf16* res; float* out;
    __device__ __forceinline__ void operator()(const f32x4 (&acc)[2][2][4][2], const pg8::Unit& u, int wr, int wc, int fr, int fq) const {
        const int row0 = u.pm * 256 + wr * 64 + fr, col0 = u.pn * 256 + wc * 32 + 4 * fq;
#pragma unroll
        for (int ai = 0; ai < 2; ++ai)
#pragma unroll
            for (int m = 0; m < 4; ++m) { const size_t off = (size_t)(row0 + ai * 128 + m * 16) * D + col0;
#pragma unroll
                for (int bj = 0; bj < 2; ++bj)
#pragma unroll
                    for (int n = 0; n < 2; ++n) { const v2u rw = *(const v2u*)(res + off + bj * 128 + n * 16);
                        const f32x4 r = (f32x4){pg8::bf_lo(rw.x), pg8::bf_hi(rw.x), pg8::bf_lo(rw.y), pg8::bf_hi(rw.y)};
                        *(f32x4*)(out + off + bj * 128 + n * 16) = r * ALPHA + acc[ai][bj][m][n]; } }
    }
};
struct EpiProj {
    static constexpr bool PERM = true;
    const bf16* GATES; bf16* MRG;
    __device__ __forceinline__ void operator()(const f32x4 (&acc)[2][2][4][2], const pg8::Unit& u, int wr, int wc, int fr, int fq) const {
        const int row0 = u.pm * 256 + wr * 64 + fr, col0 = u.pn * 256 + wc * 32 + 8 * fq;
#pragma unroll
        for (int ai = 0; ai < 2; ++ai)
#pragma unroll
            for (int m = 0; m < 4; ++m) { const int row = row0 + ai * 128 + m * 16;
#pragma unroll
                for (int bj = 0; bj < 2; ++bj) { const int col = col0 + bj * 128;
                    const v4u gw = *(const v4u*)(GATES + (size_t)row * (2 * D) + u.kind * D + col);
                    float o[8]; const f32x4 a0 = acc[ai][bj][m][0], a1 = acc[ai][bj][m][1];
                    o[0] = pg8::bf_lo(gw.x) * a0[0]; o[1] = pg8::bf_hi(gw.x) * a0[1]; o[2] = pg8::bf_lo(gw.y) * a0[2]; o[3] = pg8::bf_hi(gw.y) * a0[3];
                    o[4] = pg8::bf_lo(gw.z) * a1[0]; o[5] = pg8::bf_hi(gw.z) * a1[1]; o[6] = pg8::bf_lo(gw.w) * a1[2]; o[7] = pg8::bf_hi(gw.w) * a1[3];
                    bf16* p = MRG + (size_t)row * D + col;
                    if (u.kind == 1) {
                        const unsigned long long q0 = __hip_atomic_load((const unsigned long long*)p, RLX_AGENT), q1 = __hip_atomic_load((const unsigned long long*)p + 1, RLX_AGENT);
                        const unsigned w0 = (unsigned)q0, w1 = (unsigned)(q0 >> 32), w2 = (unsigned)q1, w3 = (unsigned)(q1 >> 32);
                        o[0] += pg8::bf_lo(w0); o[1] += pg8::bf_hi(w0); o[2] += pg8::bf_lo(w1); o[3] += pg8::bf_hi(w1); o[4] += pg8::bf_lo(w2); o[5] += pg8::bf_hi(w2); o[6] += pg8::bf_lo(w3); o[7] += pg8::bf_hi(w3); }
                    v4u w; w.x = pg8::cvt_pk_bf16(o[0], o[1]); w.y = pg8::cvt_pk_bf16(o[2], o[3]); w.z = pg8::cvt_pk_bf16(o[4], o[5]); w.w = pg8::cvt_pk_bf16(o[6], o[7]);
                    *(v4u*)p = w; } }
    }
};

struct Ctx { LAS unsigned char* lds; int tid, lane, wave, G, gw, NGW; };
__device__ __forceinline__ float wave_sum(float v) {
#pragma unroll
    for (int o = 1; o < 64; o <<= 1) v += __shfl_xor(v, o);
    return v;
}
template <class RowMap>
__device__ __forceinline__ void tr_item(const float* W, int ldw, int k0, int n0, bf16* WT, int ldt, const RowMap& rm, LAS float* scr, int lane) {
#pragma unroll 8
    for (int i = 0; i < 32; ++i) { const int kk = 2 * i + (lane >> 5); scr[kk * 33 + (lane & 31)] = W[(size_t)(k0 + kk) * ldw + n0 + (lane & 31)]; }
    LDS_WAIT(); asm volatile("" ::: "memory");
    const int c = lane & 7;
#pragma unroll
    for (int j = 0; j < 4; ++j) { const int n = (lane >> 3) + 8 * j; const LAS float* s = scr + (8 * c) * 33 + n;
        v4u o; o.x = pk2(s[0 * 33], s[1 * 33]); o.y = pk2(s[2 * 33], s[3 * 33]); o.z = pk2(s[4 * 33], s[5 * 33]); o.w = pk2(s[6 * 33], s[7 * 33]);
        *(GAS v4u*)(WT + (size_t)rm(n0 + n) * ldt + k0 + 8 * c) = o; }
    LDS_WAIT(); asm volatile("" ::: "memory");
}
template <class RowMap>
__device__ __forceinline__ void tr_matrix(const Ctx& C, const float* W, int ldw, int K, int ncol0, int ncols, bf16* WT, int ldt, const RowMap& rm) {
    LAS float* scr = (LAS float*)(C.lds + RING_OFF + C.wave * 16384);
    const int nblk = ncols / 32, nitems = (K / 64) * nblk;
    for (int it = C.gw; it < nitems; it += C.NGW) { const int kb = it / nblk, nb = it % nblk; tr_item(W, ldw, 64 * kb, ncol0 + 32 * nb, WT, ldt, rm, scr, C.lane); }
}
struct RmOff { int off; __device__ __forceinline__ int operator()(int n) const { return n + off; } };
struct RmGU { int up; __device__ __forceinline__ int operator()(int n) const { return (n >> 7) * 256 + (n & 127) + up; } };

struct Inputs { const float *x, *ln1g, *ln1b, *w1g, *w1u, *w1d, *win, *bin, *relb, *wpa, *wpf, *wout, *ln2g, *ln2b, *w2g, *w2u, *w2d, *ln3g, *ln3b; };

__device__ __forceinline__ int t5_bucket(int rel) {
    const int ret = rel > 0 ? 16 : 0; const int n = rel < 0 ? -rel : rel;
    const float nf = (float)(n > 1 ? n : 1);
    int large = 8 + (int)(logf(nf / 8.0f) / 4.852030263919617f * 8.0f);
    large = large < 15 ? large : 15;
    return ret + (n < 8 ? n : large);
}

__device__ __forceinline__ void p0_prologue(const Ctx& C, const Inputs& I, unsigned char* ws) {
    bf16* W1A = (bf16*)(ws + WS_W1A); bf16* W1D = (bf16*)(ws + WS_W1D); bf16* W2A = (bf16*)(ws + WS_W2A); bf16* W2D = (bf16*)(ws + WS_W2D);
    bf16* WIN = (bf16*)(ws + WS_WIN); bf16* WSW = (bf16*)(ws + WS_WSW); bf16* WPA = (bf16*)(ws + WS_WPA); bf16* WPF = (bf16*)(ws + WS_WPF); bf16* WOUT = (bf16*)(ws + WS_WOUT);
    float* BIASN = (float*)(ws + WS_TAB + TAB_BIASN); float* BIASW = (float*)(ws + WS_TAB + TAB_BIASW); float* TBL = (float*)(ws + WS_TAB + TAB_TBL);
    float* COS = (float*)(ws + WS_TAB + TAB_COS); float* SIN = (float*)(ws + WS_TAB + TAB_SIN);
    bf16* XB = (bf16*)(ws + WS_XB);
    LAS float* lc = (LAS float*)(C.lds + LTAB_OFF); LAS float* ls = lc + 128;
    if (C.tid < 128) { lc[C.tid] = cospif((float)C.tid / 64.0f); ls[C.tid] = sinpif((float)C.tid / 64.0f); }
    __syncthreads();
    tr_matrix(C, I.w1g, FF, D, 0, FF, W1A, D, RmGU{0});   tr_matrix(C, I.w1u, FF, D, 0, FF, W1A, D, RmGU{128});
    tr_matrix(C, I.w2g, FF, D, 0, FF, W2A, D, RmGU{0});   tr_matrix(C, I.w2u, FF, D, 0, FF, W2A, D, RmGU{128});
    tr_matrix(C, I.w1d, D, FF, 0, D, W1D, FFP, RmOff{0}); tr_matrix(C, I.w2d, D, FF, 0, D, W2D, FFP, RmOff{0});
    tr_matrix(C, I.win, 7168, D, 0, AQ, WIN, D, RmOff{0});
    tr_matrix(C, I.win, 7168, D, AQ, AQ, WIN, D, RmOff{0});
    tr_matrix(C, I.win, 7168, D, 3 * AQ + FW, 2 * D, WIN, D, RmOff{2 * AQ - (3 * AQ + FW)});
    tr_matrix(C, I.win, 7168, D, 2 * AQ, AQ, WSW, D, RmOff{-2 * AQ});
    tr_matrix(C, I.wpa, D, FW, 0, D, WPA, FW, RmOff{0}); tr_matrix(C, I.wpf, D, FW, 0, D, WPF, FW, RmOff{0}); tr_matrix(C, I.wout, D, D, 0, D, WOUT, D, RmOff{0});
    const int gt = C.gw * 64 + C.lane, NGT = C.NGW * 64;
    for (int i = gt; i < 2 * 128 * (D / 8); i += NGT) { const int w = i / (128 * (D / 8)), r = (i / (D / 8)) % 128, c8 = i % (D / 8); const int row = 21 * 256 + 64 + (r & 63) + (r >> 6) * 128;
        *(v4u*)((w ? W2A : W1A) + (size_t)row * D + c8 * 8) = (v4u){0u, 0u, 0u, 0u}; }
    for (int i = gt; i < 2 * D * 8; i += NGT) { const int w = i / (D * 8), r = (i / 8) % D, c8 = i % 8; *(v4u*)((w ? W2D : W1D) + (size_t)r * FFP + FF + c8 * 8) = (v4u){0u, 0u, 0u, 0u}; }
    { LAS float* scr = (LAS float*)(C.lds + RING_OFF + C.wave * 16384);
      for (int it = C.gw; it < D * 4; it += C.NGW) { const int k = it >> 2, g = it & 3;
          const float* src = I.win + (size_t)k * 7168 + 3 * AQ + g * 128;
          scr[C.lane] = src[C.lane]; scr[C.lane + 64] = src[C.lane + 64];
          LDS_WAIT(); asm volatile("" ::: "memory");
          float ar0 = 0.f, ai0 = 0.f, ar1 = 0.f, ai1 = 0.f;
          for (int c = 0; c < 128; ++c) { const float w = scr[c]; const int i0 = (c * C.lane) & 127, i1 = (c * (C.lane + 64)) & 127;
              ar0 += w * lc[i0]; ai0 -= w * ls[i0]; ar1 += w * lc[i1]; ai1 -= w * ls[i1]; }
          WSW[(size_t)(AQ + g * 128 + C.lane) * D + k] = (bf16)f2bf(ar0);        WSW[(size_t)(AQ + g * 128 + C.lane + 64) * D + k] = (bf16)f2bf(ar1);
          WSW[(size_t)(AQ + 512 + g * 128 + C.lane) * D + k] = (bf16)f2bf(ai0);  WSW[(size_t)(AQ + 512 + g * 128 + C.lane + 64) * D + k] = (bf16)f2bf(ai1);
          LDS_WAIT(); asm volatile("" ::: "memory"); } }
    for (int i = gt; i < NIN; i += NGT) BIASN[i] = I.bin[i < 2 * AQ ? i : i + AQ + FW];
    for (int i = gt; i < NSW; i += NGT) {
        if (i < AQ) BIASW[i] = I.bin[2 * AQ + i];
        else { const int z = i - AQ, ri = z >> 9, g = (z >> 7) & 3, cp = z & 127; float a = 0.f;
            for (int c = 0; c < 128; ++c) { const int ix = (c * cp) & 127; a += I.bin[3 * AQ + g * 128 + c] * (ri ? -ls[ix] : lc[ix]); }
            BIASW[i] = a; } }
    for (int i = gt; i < NH * 129; i += NGT) { const int hd = i / 129, off = i % 129 - 64, dil = 1 << (2 * (hd >> 2)); TBL[i] = I.relb[t5_bucket(off * dil) * NH + hd]; }
    for (int i = gt; i < 8192; i += NGT) { COS[i] = cospif((float)i / 4096.0f); SIN[i] = sinpif((float)i / 4096.0f); }
    for (int m = C.gw; m < T; m += C.NGW) { const GAS f32x4* xr = (const GAS f32x4*)(I.x + (size_t)m * D) + C.lane; GAS unsigned long long* o8 = (GAS unsigned long long*)(XB + (size_t)m * D) + C.lane;
#pragma unroll
        for (int j = 0; j < 4; ++j) { const f32x4 v = xr[64 * j]; o8[64 * j] = (unsigned long long)pk2(v.x, v.y) | ((unsigned long long)pk2(v.z, v.w) << 32); } }
}

__device__ __forceinline__ void ln_pass(const Ctx& C, const float* v, float* outf, bf16* outb, const float* g, const float* b) {
    f32x4 gv[4], bv[4];
#pragma unroll
    for (int j = 0; j < 4; ++j) { gv[j] = *((const f32x4*)g + C.lane + 64 * j); bv[j] = *((const f32x4*)b + C.lane + 64 * j); }
    for (int m = C.gw; m < T; m += C.NGW) {
        const f32x4* xr = (const f32x4*)(v + (size_t)m * D) + C.lane;
        f32x4 x[4]; float s = 0.f;
#pragma unroll
        for (int j = 0; j < 4; ++j) { x[j] = xr[64 * j]; s += (x[j].x + x[j].y) + (x[j].z + x[j].w); }
        const float mean = wave_sum(s) * (1.f / D); float s2 = 0.f;
#pragma unroll
        for (int j = 0; j < 4; ++j) { x[j] = x[j] - mean; s2 += (x[j].x * x[j].x + x[j].y * x[j].y) + (x[j].z * x[j].z + x[j].w * x[j].w); }
        const float rstd = 1.f / sqrtf(wave_sum(s2) * (1.f / D) + LN_EPS);
#pragma unroll
        for (int j = 0; j < 4; ++j) { const f32x4 y = x[j] * rstd * gv[j] + bv[j];
            if (outf) *((f32x4*)(outf + (size_t)m * D) + C.lane + 64 * j) = y;
            if (outb) *((unsigned long long*)(outb + (size_t)m * D) + C.lane + 64 * j) = (unsigned long long)pk2(y.x, y.y) | ((unsigned long long)pk2(y.z, y.w) << 32); }
    }
}

#ifdef MK_SIMPLE
__device__ __forceinline__ void attn_simple(const Ctx& C, bf16* QB, const bf16* KB, const bf16* VT, float* LSE, const float* TBL) {
    LAS float* slog = (LAS float*)(C.lds + RING_OFF + C.wave * 1024);
    for (int it = C.gw; it < T * NH; it += C.NGW) {
        const int tok = it / NH, hd = it % NH, g = hd >> 2, sh = 2 * g, L = SEQ >> sh, b = tok >> 13, s = tok & (SEQ - 1), r = s & ((1 << sh) - 1), m = s >> sh;
        const unsigned qw = *(const unsigned*)(QB + (size_t)tok * AQ + hd * HD + 2 * C.lane);
        const float q0 = pg8::bf_lo(qw), q1 = pg8::bf_hi(qw);
        float mx = -3.0e38f;
        for (int j = -64; j <= 64; ++j) { const int mk = m + j; float lg = -1e30f;
            if (mk >= 0 && mk < L) { const int kt = b * SEQ + (mk << sh) + r; const unsigned kw = *(const unsigned*)(KB + (size_t)kt * AQ + hd * HD + 2 * C.lane);
                lg = wave_sum(q0 * pg8::bf_lo(kw) + q1 * pg8::bf_hi(kw)) + TBL[hd * 129 + j + 64] * LOG2E; }
            if (C.lane == 0) slog[j + 64] = lg;
            mx = fmaxf(mx, lg); }
        LDS_WAIT(); asm volatile("" ::: "memory");
        float den = 0.f, o0 = 0.f, o1 = 0.f;
        const bf16* vrow = VT + ((size_t)(b * AQ + hd * HD + 2 * C.lane) * SEQ + r * L);
        for (int j = -64; j <= 64; ++j) { const int mk = m + j;
            if (mk >= 0 && mk < L) { const float p = exp2f(slog[j + 64] - mx); den += p; const int pos = swap23(mk);
                o0 += p * bf2f(vrow[pos]); o1 += p * bf2f(vrow[SEQ + pos]); } }
        const float inv = 1.0f / den;
        *(unsigned*)(QB + (size_t)tok * AQ + hd * HD + 2 * C.lane) = pk2(o0 * inv, o1 * inv);
        if (C.lane == 0) LSE[(size_t)tok * NH + hd] = (mx + log2f(den)) * LN2;
        LDS_WAIT(); asm volatile("" ::: "memory");
    }
}
__device__ __forceinline__ void combine_simple(const Ctx& C, const bf16* QB, const float* LSE, bf16* ATT) {
    for (int tok = C.gw; tok < T; tok += C.NGW) {
#pragma unroll
        for (int h = 0; h < 4; ++h) {
            const float l0 = LSE[(size_t)tok * NH + h], l1 = LSE[(size_t)tok * NH + 4 + h], l2 = LSE[(size_t)tok * NH + 8 + h];
            const float mx = fmaxf(l0, fmaxf(l1, l2)); float w0 = __expf(l0 - mx), w1 = __expf(l1 - mx), w2 = __expf(l2 - mx); const float inv = 1.0f / (w0 + w1 + w2); w0 *= inv; w1 *= inv; w2 *= inv;
            const unsigned a = *(const unsigned*)(QB + (size_t)tok * AQ + h * HD + 2 * C.lane), bq = *(const unsigned*)(QB + (size_t)tok * AQ + (4 + h) * HD + 2 * C.lane), c = *(const unsigned*)(QB + (size_t)tok * AQ + (8 + h) * HD + 2 * C.lane);
            *(unsigned*)(ATT + (size_t)tok * FW + h * HD + 2 * C.lane) = pk2(w0 * pg8::bf_lo(a) + w1 * pg8::bf_lo(bq) + w2 * pg8::bf_lo(c), w0 * pg8::bf_hi(a) + w1 * pg8::bf_hi(bq) + w2 * pg8::bf_hi(c));
        }
    }
}
__device__ __forceinline__ void fft1_simple(const Ctx& C, const bf16* Z1, bf16* YP, const float* COS, const float* SIN) {
    for (int it = C.gw; it < FW * BATCH * 128; it += C.NGW) {
        const int s2 = it & 127, cb = it >> 7, k1 = C.lane;
        const bf16* z = Z1 + (size_t)it * 128;
        float yr = 0.f, yi = 0.f;
        for (int s1 = 0; s1 < 64; ++s1) { const float zr = bf2f(z[s1]), zi = bf2f(z[64 + s1]); const int ix = ((s1 * k1) & 63) * 128; const float c = COS[ix], s = SIN[ix];
            yr += zr * c + zi * s; yi += zi * c - zr * s; }
        const int ix2 = s2 * k1; const float c2 = COS[ix2], sn2 = SIN[ix2];
        const float pr = yr * c2 + yi * sn2, pi = yi * c2 - yr * sn2;
        bf16* o = YP + ((size_t)(cb * 64 + k1) * 2) * 128 + s2;
        o[0] = (bf16)f2bf(pr); o[128] = (bf16)f2bf(pi);
    }
}
__device__ __forceinline__ void fft2_simple(const Ctx& C, const bf16* YP, bf16* FOUR, const float* COS, const float* SIN) {
    for (int it = C.gw; it < BATCH * 64 * FW; it += C.NGW) {
        const int ch = it & 511, k1 = (it >> 9) & 63, b = it >> 15;
        const bf16* y = YP + ((size_t)((ch * 4 + b) * 64 + k1) * 2) * 128;
        float a0 = 0.f, a1 = 0.f;
        for (int s2 = 0; s2 < 128; ++s2) { const float yr = bf2f(y[s2]), yi = bf2f(y[128 + s2]); const int i0 = ((s2 * C.lane) & 127) * 64, i1 = ((s2 * (C.lane + 64)) & 127) * 64;
            a0 += yr * COS[i0] + yi * SIN[i0]; a1 += yr * COS[i1] + yi * SIN[i1]; }
        FOUR[(size_t)(b * SEQ + k1 + 64 * C.lane) * FW + ch] = (bf16)f2bf(a0 * (1.0f / 1024.0f));
        FOUR[(size_t)(b * SEQ + k1 + 64 * (C.lane + 64)) * FW + ch] = (bf16)f2bf(a1 * (1.0f / 1024.0f));
    }
}
#endif

typedef float f32x16 __attribute__((ext_vector_type(16)));
typedef short bf16x8 __attribute__((ext_vector_type(8)));
__device__ __forceinline__ bf16x8 pack8(float a0, float a1, float a2, float a3, float a4, float a5, float a6, float a7) {
    v4u w; w.x = pg8::cvt_pk_bf16(a0, a1); w.y = pg8::cvt_pk_bf16(a2, a3); w.z = pg8::cvt_pk_bf16(a4, a5); w.w = pg8::cvt_pk_bf16(a6, a7); return __builtin_bit_cast(bf16x8, w);
}
__device__ __forceinline__ void attn_mfma(const Ctx& C, bf16* QB, const bf16* KB, const bf16* VT, float* LSE, const float* TBL) {
    LAS float* ltbl = (LAS float*)(C.lds + RING_OFF);
    for (int i = C.tid; i < NH * 129; i += NWAVES * 64) ltbl[i] = TBL[i] * LOG2E;
    __syncthreads();
    const int r32 = C.lane & 31, h = C.lane >> 5;
    for (int wu = C.gw; wu < T * NH / 32; wu += C.NGW) {
        const int bh = wu >> 8, w256 = wu & 255, b = bh / NH, hd = bh % NH, sh = 2 * (hd >> 2), L = SEQ >> sh, nq = L >> 5, r = w256 / nq, q0 = (w256 % nq) * 32;
        const size_t qtok = (size_t)b * SEQ + ((size_t)(q0 + r32) << sh) + r;
        const bf16* qp = QB + qtok * AQ + hd * HD + 8 * h;
        bf16x8 qf[8];
#pragma unroll
        for (int ks = 0; ks < 8; ++ks) qf[ks] = *(const bf16x8*)(qp + 16 * ks);
        f32x16 S[5];
        const LAS float* tb = ltbl + hd * 129 + 64 - r32;
#pragma unroll
        for (int t = 0; t < 5; ++t) {
            const int ts = q0 - 64 + 32 * t;
            if (ts >= 0 && ts < L) {
#pragma unroll
                for (int i = 0; i < 16; ++i) { const int kr = (i & 3) + 8 * (i >> 2) + 4 * h; const int off = 32 * t + kr - 64 - r32;
                    float v = tb[32 * t + kr - 64];
                    if (t == 0) v = (off >= -64) ? v : -1e30f;
                    if (t == 4) v = (off <= 64) ? v : -1e30f;
                    S[t][i] = v; }
                const size_t ktok = (size_t)b * SEQ + ((size_t)(ts + r32) << sh) + r;
                const bf16* kp = KB + ktok * AQ + hd * HD + 8 * h;
                bf16x8 kf[8];
#pragma unroll
                for (int ks = 0; ks < 8; ++ks) kf[ks] = *(const bf16x8*)(kp + 16 * ks);
#pragma unroll
                for (int ks = 0; ks < 8; ++ks) S[t] = __builtin_amdgcn_mfma_f32_32x32x16_bf16(kf[ks], qf[ks], S[t], 0, 0, 0);
            } else {
#pragma unroll
                for (int i = 0; i < 16; ++i) S[t][i] = -1e30f;
            }
        }
        float mx = -3.0e38f;
#pragma unroll
        for (int t = 0; t < 5; ++t)
#pragma unroll
            for (int i = 0; i < 16; ++i) mx = fmaxf(mx, S[t][i]);
        mx = fmaxf(mx, __shfl_xor(mx, 32));
        float den = 0.f;
#pragma unroll
        for (int t = 0; t < 5; ++t)
#pragma unroll
            for (int i = 0; i < 16; ++i) { const float p = __builtin_amdgcn_exp2f(S[t][i] - mx); S[t][i] = p; den += p; }
        den += __shfl_xor(den, 32);
        f32x16 o[4];
#pragma unroll
        for (int db = 0; db < 4; ++db)
#pragma unroll
            for (int i = 0; i < 16; ++i) o[db][i] = 0.f;
        const bf16* vbase = VT + ((size_t)(b * AQ + hd * HD + r32) * SEQ + (size_t)r * L + 8 * h);
#pragma unroll
        for (int t = 0; t < 5; ++t) {
            const int ts = q0 - 64 + 32 * t;
            if (ts >= 0 && ts < L) {
#pragma unroll
                for (int s = 0; s < 2; ++s) {
                    const bf16x8 pf = pack8(S[t][8 * s], S[t][8 * s + 1], S[t][8 * s + 2], S[t][8 * s + 3], S[t][8 * s + 4], S[t][8 * s + 5], S[t][8 * s + 6], S[t][8 * s + 7]);
#pragma unroll
                    for (int db = 0; db < 4; ++db) { const bf16x8 vf = *(const bf16x8*)(vbase + (size_t)(db * 32) * SEQ + ts + 16 * s);
                        o[db] = __builtin_amdgcn_mfma_f32_32x32x16_bf16(vf, pf, o[db], 0, 0, 0); }
                }
            }
        }
        const float inv = 1.0f / den;
        bf16* op = QB + qtok * AQ + hd * HD + 4 * h;
#pragma unroll
        for (int db = 0; db < 4; ++db)
#pragma unroll
            for (int i4 = 0; i4 < 4; ++i4) { v2u w; w.x = pg8::cvt_pk_bf16(o[db][4 * i4] * inv, o[db][4 * i4 + 1] * inv); w.y = pg8::cvt_pk_bf16(o[db][4 * i4 + 2] * inv, o[db][4 * i4 + 3] * inv);
                *(v2u*)(op + db * 32 + 8 * i4) = w; }
        if (h == 0) LSE[qtok * NH + hd] = (mx + __builtin_amdgcn_logf(den)) * LN2;
    }
    __syncthreads();
}
__device__ __forceinline__ void combine_vec(const Ctx& C, const bf16* QB, const float* LSE, bf16* ATT) {
    const int h = C.lane >> 4, d0 = (C.lane & 15) * 8;
    for (int tok = C.gw; tok < T; tok += C.NGW) {
        const float l0 = LSE[(size_t)tok * NH + h], l1 = LSE[(size_t)tok * NH + 4 + h], l2 = LSE[(size_t)tok * NH + 8 + h];
        const float mx = fmaxf(l0, fmaxf(l1, l2)); float w0 = __expf(l0 - mx), w1 = __expf(l1 - mx), w2 = __expf(l2 - mx); const float inv = 1.0f / (w0 + w1 + w2); w0 *= inv; w1 *= inv; w2 *= inv;
        const bf16* qp = QB + (size_t)tok * AQ + h * HD + d0;
        const v4u a = *(const v4u*)qp, bq = *(const v4u*)(qp + 4 * HD), c = *(const v4u*)(qp + 8 * HD);
        v4u o;
        o.x = pg8::cvt_pk_bf16(w0 * pg8::bf_lo(a.x) + w1 * pg8::bf_lo(bq.x) + w2 * pg8::bf_lo(c.x), w0 * pg8::bf_hi(a.x) + w1 * pg8::bf_hi(bq.x) + w2 * pg8::bf_hi(c.x));
        o.y = pg8::cvt_pk_bf16(w0 * pg8::bf_lo(a.y) + w1 * pg8::bf_lo(bq.y) + w2 * pg8::bf_lo(c.y), w0 * pg8::bf_hi(a.y) + w1 * pg8::bf_hi(bq.y) + w2 * pg8::bf_hi(c.y));
        o.z = pg8::cvt_pk_bf16(w0 * pg8::bf_lo(a.z) + w1 * pg8::bf_lo(bq.z) + w2 * pg8::bf_lo(c.z), w0 * pg8::bf_hi(a.z) + w1 * pg8::bf_hi(bq.z) + w2 * pg8::bf_hi(c.z));
        o.w = pg8::cvt_pk_bf16(w0 * pg8::bf_lo(a.w) + w1 * pg8::bf_lo(bq.w) + w2 * pg8::bf_lo(c.w), w0 * pg8::bf_hi(a.w) + w1 * pg8::bf_hi(bq.w) + w2 * pg8::bf_hi(c.w));
        *(v4u*)(ATT + (size_t)tok * FW + h * HD + d0) = o;
    }
}
constexpr int F1_LD = 136, F2_LD = 264;
__device__ __forceinline__ void fft1_mfma(const Ctx& C, const bf16* Z1, bf16* YP, const float* COS, const float* SIN) {
    LAS bf16* F1 = (LAS bf16*)(C.lds + RING_OFF);
    for (int idx = C.tid; idx < 128 * 128; idx += NWAVES * 64) { const int m = idx >> 7, k = idx & 127, k1 = m & 63, ri = m >> 6, s1 = k & 63, part = k >> 6, ix = ((s1 * k1) & 63) * 128;
        const float c = COS[ix], s = SIN[ix]; const float val = (ri == 0) ? (part == 0 ? c : s) : (part == 0 ? -s : c); F1[m * F1_LD + k] = (bf16)f2bf(val); }
    __syncthreads();
    const int r32 = C.lane & 31, h = C.lane >> 5;
    for (int wu = C.gw; wu < FW * BATCH * 128 / 32; wu += C.NGW) {
        const int n = wu * 32 + r32;
        const bf16* zp = Z1 + (size_t)n * 128 + 8 * h;
        bf16x8 bfr[8];
#pragma unroll
        for (int ks = 0; ks < 8; ++ks) bfr[ks] = *(const bf16x8*)(zp + 16 * ks);
        f32x16 acc[4];
#pragma unroll
        for (int mb = 0; mb < 4; ++mb)
#pragma unroll
            for (int i = 0; i < 16; ++i) acc[mb][i] = 0.f;
#pragma unroll
        for (int ks = 0; ks < 8; ++ks)
#pragma unroll
            for (int mb = 0; mb < 4; ++mb) { const bf16x8 af = *(const LAS bf16x8*)(F1 + (mb * 32 + r32) * F1_LD + 16 * ks + 8 * h); acc[mb] = __builtin_amdgcn_mfma_f32_32x32x16_bf16(af, bfr[ks], acc[mb], 0, 0, 0); }
        const int s2 = n & 127, cb = n >> 7;
#pragma unroll
        for (int mb = 0; mb < 2; ++mb)
#pragma unroll
            for (int i = 0; i < 16; ++i) { const int k1 = mb * 32 + (i & 3) + 8 * (i >> 2) + 4 * h; const float yr = acc[mb][i], yi = acc[mb + 2][i];
                const float x = (float)(s2 * k1) * (1.0f / 8192.0f); const float c2 = __builtin_amdgcn_cosf(x), sn = __builtin_amdgcn_sinf(x);
                bf16* o = YP + ((size_t)(cb * 64 + k1) * 2) * 128 + s2;
                o[0] = (bf16)f2bf(yr * c2 + yi * sn); o[128] = (bf16)f2bf(yi * c2 - yr * sn); }
    }
    __syncthreads();
}
__device__ __forceinline__ void fft2_mfma(const Ctx& C, const bf16* YP, bf16* FOUR, const float* COS, const float* SIN) {
    LAS bf16* F2 = (LAS bf16*)(C.lds + RING_OFF);
    for (int idx = C.tid; idx < 128 * 256; idx += NWAVES * 64) { const int k2 = idx >> 8, k = idx & 255, s2 = k & 127, part = k >> 7, ix = ((s2 * k2) & 127) * 64;
        F2[k2 * F2_LD + k] = (bf16)f2bf((part ? SIN[ix] : COS[ix]) * (1.0f / 1024.0f)); }
    __syncthreads();
    const int r32 = C.lane & 31, h = C.lane >> 5;
    for (int wu = C.gw; wu < BATCH * 64 * (FW / 32); wu += C.NGW) {
        const int ch0 = (wu & 15) * 32, k1 = (wu >> 4) & 63, b = wu >> 10;
        const bf16* yp = YP + ((size_t)((ch0 + r32) * 4 + b) * 64 + k1) * 256 + 8 * h;
        f32x16 acc[4];
#pragma unroll
        for (int mb = 0; mb < 4; ++mb)
#pragma unroll
            for (int i = 0; i < 16; ++i) acc[mb][i] = 0.f;
#pragma unroll 1
        for (int kh = 0; kh < 2; ++kh) {
            bf16x8 bfr[8];
#pragma unroll
            for (int ks = 0; ks < 8; ++ks) bfr[ks] = *(const bf16x8*)(yp + 128 * kh + 16 * ks);
#pragma unroll
            for (int ks = 0; ks < 8; ++ks)
#pragma unroll
                for (int mb = 0; mb < 4; ++mb) { const bf16x8 af = *(const LAS bf16x8*)(F2 + (mb * 32 + r32) * F2_LD + 128 * kh + 16 * ks + 8 * h); acc[mb] = __builtin_amdgcn_mfma_f32_32x32x16_bf16(af, bfr[ks], acc[mb], 0, 0, 0); }
        }
#pragma unroll
        for (int mb = 0; mb < 4; ++mb)
#pragma unroll
            for (int i = 0; i < 16; ++i) { const int k2 = mb * 32 + (i & 3) + 8 * (i >> 2) + 4 * h; FOUR[(size_t)(b * SEQ + k1 + 64 * k2) * FW + ch0 + r32] = (bf16)f2bf(acc[mb][i]); }
    }
    __syncthreads();
}

struct Args { const float* in[19]; float* out; unsigned char* ws; int ph_lo, ph_hi, li, pad; };
__global__ void __launch_bounds__(NWAVES * 64, 2) mk_fwd(Args args) {
    extern __shared__ __attribute__((aligned(16))) unsigned char lds_raw[];
    Ctx C; C.lds = (LAS unsigned char*)lds_raw; C.tid = threadIdx.x; C.lane = C.tid & 63; C.wave = __builtin_amdgcn_readfirstlane(C.tid >> 6);
    C.G = gridDim.x; const int bx = blockIdx.x; const int vcu = (C.G % 8 == 0) ? (bx % 8) * (C.G / 8) + bx / 8 : bx;
    C.gw = vcu * NWAVES + C.wave; C.NGW = C.G * NWAVES;
    volatile LAS unsigned* MISC = (volatile LAS unsigned*)(C.lds + MISC_OFF);
    unsigned char* ws = args.ws;
    unsigned* ctl = (unsigned*)(ws + WS_CTL);
    for (int u = C.tid; u < (LDS_BYTES - LDSCTL_OFF) / 4; u += NWAVES * 64) ((LAS unsigned*)(C.lds + LDSCTL_OFF))[u] = 0u;
    __syncthreads();
    XcdBarrier bar; bar.bar = ctl + CW_BAR; bar.x = 0; bar.st = nullptr;
    if (N_LAUNCHES == 1) bar = xcd_barrier_post(ctl + CW_BAR, MISC + 8);
    Inputs I; { const float* const* p = args.in; I.x = p[0]; I.ln1g = p[1]; I.ln1b = p[2]; I.w1g = p[3]; I.w1u = p[4]; I.w1d = p[5]; I.win = p[6]; I.bin = p[7]; I.relb = p[8]; I.wpa = p[9]; I.wpf = p[10]; I.wout = p[11];
        I.ln2g = p[12]; I.ln2b = p[13]; I.w2g = p[14]; I.w2u = p[15]; I.w2d = p[16]; I.ln3g = p[17]; I.ln3b = p[18]; }
    float* OUT = args.out;
    bf16* W1A = (bf16*)(ws + WS_W1A); bf16* W1D = (bf16*)(ws + WS_W1D); bf16* W2A = (bf16*)(ws + WS_W2A); bf16* W2D = (bf16*)(ws + WS_W2D);
    bf16* WIN = (bf16*)(ws + WS_WIN); bf16* WSW = (bf16*)(ws + WS_WSW); bf16* WPA = (bf16*)(ws + WS_WPA); bf16* WOUT = (bf16*)(ws + WS_WOUT);
    float* BIASN = (float*)(ws + WS_TAB + TAB_BIASN); float* BIASW = (float*)(ws + WS_TAB + TAB_BIASW); float* TBL = (float*)(ws + WS_TAB + TAB_TBL);
    float* COS = (float*)(ws + WS_TAB + TAB_COS); float* SIN = (float*)(ws + WS_TAB + TAB_SIN); float* LSE = (float*)(ws + WS_TAB + TAB_LSE);
    bf16* XB = (bf16*)(ws + WS_XB); bf16* ACT = (bf16*)(ws + WS_ACT); bf16* QB = (bf16*)(ws + WS_QB); bf16* KB = (bf16*)(ws + WS_KB); bf16* VT = (bf16*)(ws + WS_VT);
    bf16* ATT = (bf16*)(ws + WS_ATT); bf16* FOUR = (bf16*)(ws + WS_FOUR); bf16* MRG = (bf16*)(ws + WS_MRG); bf16* YP = (bf16*)(ws + WS_YP); bf16* Z1 = (bf16*)(ws + WS_Z1);
    bf16* GATES = (bf16*)OUT;
    LAS unsigned char* ring = C.lds + RING_OFF;

    const int lo = args.ph_lo, hi = args.ph_hi;
#define IN(k) (lo <= (k) && (k) < hi)
#define SEAM(k) do { if (IN(k) && IN((k) + 1)) xcd_barrier(bar); } while (0)
    if (IN(0)) { p0_prologue(C, I, ws); VM_WAIT(); __syncthreads(); } SEAM(0);
    if (IN(1)) { SchedStd S{XB, W1A, D, D, T / 256, NUP / 256, C.G, bx}; EpiSwiGLU E{ACT}; pg8::gemm_phase(ring, D, S, E); } SEAM(1);
    if (IN(2)) { SchedStd S{ACT, W1D, FFP, FFP, T / 256, D / 256, C.G, bx}; EpiDown E{I.x, OUT}; pg8::gemm_phase(ring, FFP, S, E); } SEAM(2);
    if (IN(3)) { ln_pass(C, OUT, nullptr, XB, I.ln1g, I.ln1b); } SEAM(3);
    if (IN(4)) { { SchedStd S{XB, WIN, D, D, T / 256, NIN / 256, C.G, bx}; EpiInproj E{QB, KB, GATES, BIASN}; pg8::gemm_phase(ring, D, S, E); }
                 { SchedSw S{WSW, XB, C.G, bx}; EpiSw E{VT, Z1, BIASW}; pg8::gemm_phase(ring, D, S, E); } } SEAM(4);
    if (IN(5)) { attn_mfma(C, QB, KB, VT, LSE, TBL); } SEAM(5);
    if (IN(6)) { combine_vec(C, QB, LSE, ATT); fft1_mfma(C, Z1, YP, COS, SIN); } SEAM(6);
    if (IN(7)) { fft2_mfma(C, YP, FOUR, COS, SIN); } SEAM(7);
    if (IN(8)) { SchedProj S{ATT, WPA, C.G, bx}; EpiProj E{GATES, MRG}; pg8::gemm_phase(ring, FW, S, E); } SEAM(8);
    if (IN(9)) { SchedStd S{MRG, WOUT, D, D, T / 256, D / 256, C.G, bx}; EpiWout E{XB, OUT}; pg8::gemm_phase(ring, D, S, E); } SEAM(9);
    if (IN(10)) { ln_pass(C, OUT, OUT, XB, I.ln2g, I.ln2b); } SEAM(10);
    if (IN(11)) { SchedStd S{XB, W2A, D, D, T / 256, NUP / 256, C.G, bx}; EpiSwiGLU E{ACT}; pg8::gemm_phase(ring, D, S, E); } SEAM(11);
    if (IN(12)) { SchedStd S{ACT, W2D, FFP, FFP, T / 256, D / 256, C.G, bx}; EpiDown E{OUT, OUT}; pg8::gemm_phase(ring, FFP, S, E); } SEAM(12);
    if (IN(13)) { ln_pass(C, OUT, OUT, nullptr, I.ln3g, I.ln3b); }
#undef IN
#undef SEAM
}

extern "C" void kernel_launch(void* const* d_in, const int* in_sizes, int n_in, void* d_out, int out_size, void* d_ws, size_t ws_size, hipStream_t stream) {
    static int grid = 0;
    if (grid == 0) {
        if (n_in != 19 || out_size != T * D || ws_size < WS_END) { fprintf(stderr, "kernel_launch: unexpected shapes (n_in %d, out %d, ws %zu); nothing launched\n", n_in, out_size, ws_size); grid = -1; return; }
        int dev = 0, cus = 0, per_cu = 0;
        if (hipGetDevice(&dev) != hipSuccess || hipDeviceGetAttribute(&cus, hipDeviceAttributeMultiprocessorCount, dev) != hipSuccess) { grid = -1; return; }
        if (hipFuncSetAttribute((const void*)mk_fwd, hipFuncAttributeMaxDynamicSharedMemorySize, LDS_BYTES) != hipSuccess) { fprintf(stderr, "kernel_launch: hipFuncSetAttribute failed\n"); grid = -1; return; }
        if (hipOccupancyMaxActiveBlocksPerMultiprocessor(&per_cu, (const void*)mk_fwd, NWAVES * 64, LDS_BYTES) != hipSuccess || per_cu < 1) fprintf(stderr, "kernel_launch: occupancy query reports %d\n", per_cu);
        (void)hipGetLastError();
        grid = cus;
    }
    if (grid < 0) return;
    if (hipMemsetAsync((char*)d_ws + WS_CTL, 0, CTL_ZERO_BYTES, stream) != hipSuccess) return;
    Args a{};
    for (int i = 0; i < 19; ++i) a.in[i] = (const float*)d_in[i];
    a.out = (float*)d_out; a.ws = (unsigned char*)d_ws;
    if (N_LAUNCHES == 1) { a.ph_lo = 0; a.ph_hi = N_PHASES; a.li = 0; hipLaunchKernelGGL(mk_fwd, dim3(grid), dim3(NWAVES * 64), LDS_BYTES, stream, a); }
    else for (int li = 0; li < N_PHASES; ++li) { a.ph_lo = li; a.ph_hi = li + 1; a.li = li; hipLaunchKernelGGL(mk_fwd, dim3(grid), dim3(NWAVES * 64), LDS_BYTES, stream, a); }
}
```

```cpp
#include <hip/hip_runtime.h>
#include <cstdio>
#include <cstdint>

#ifndef MK_DUP
#define MK_DUP 0
#endif
#ifndef MK_N_LAUNCHES
#define MK_N_LAUNCHES 1
#endif

namespace pg8 {
#define PG8_LAS __attribute__((address_space(3)))
typedef unsigned short bf16_t;
typedef short bf16x8 __attribute__((ext_vector_type(8)));
typedef float f32x4 __attribute__((ext_vector_type(4)));
typedef float f32x2 __attribute__((ext_vector_type(2)));
typedef unsigned u32x4 __attribute__((ext_vector_type(4)));
typedef unsigned u32x2 __attribute__((ext_vector_type(2)));
constexpr int BM = 256, BK = 64, HALF = 128, HTB = HALF * BK * 2, STAGE_BYTES = 8 * HTB, NXCD = 8, WGM = 8;

__host__ __device__ __forceinline__ int lds_byte(int r, int c) { const int st = (r >> 4) * 2 + (c >> 5), rr = r & 15, cc = c & 31, ob = rr * 64 + cc * 2; return st * 1024 + (ob ^ (((ob >> 9) & 1) << 5)); }
__host__ __device__ __forceinline__ void stage_rc(int b, int& R, int& C) { const int st = b / 1024, sb = b % 1024, swz = sb ^ (((sb >> 9) & 1) << 5); R = (st >> 1) * 16 + swz / 64; C = (st & 1) * 32 + (swz % 64) / 2; }
__host__ __device__ __forceinline__ int perm32(int rho) { const int n = rho >> 4, i = rho & 15; return 8 * (i >> 2) + 4 * n + (i & 3); }

struct Unit { int pm, pn, kind; };

__device__ __forceinline__ void tile_of(int L, int nM, int nN, int& pm, int& pn) {
    const int nwg = nM * nN; int wgid = L;
    { const int q = nwg / NXCD, r = nwg % NXCD, xcd = wgid % NXCD, off = wgid / NXCD; wgid = (xcd < r ? xcd * (q + 1) : r * (q + 1) + (xcd - r) * q) + off; }
    const int nig = WGM * nN, gid = wgid / nig, fm = gid * WGM, gsz = (nM - fm) < WGM ? (nM - fm) : WGM;
    pm = fm + ((wgid % nig) % gsz); pn = (wgid % nig) / gsz;
}

__device__ __forceinline__ unsigned cvt_pk_bf16(float lo, float hi) { unsigned r; asm volatile("v_cvt_pk_bf16_f32 %0, %1, %2" : "=v"(r) : "v"(lo), "v"(hi)); return r; }
__device__ __forceinline__ float bf_lo(unsigned w) { return __uint_as_float(w << 16); }
__device__ __forceinline__ float bf_hi(unsigned w) { return __uint_as_float(w & 0xffff0000u); }

template <class Epi, class Sched>
__device__ __forceinline__ void gemm_phase(PG8_LAS unsigned char* lds, const int K, const Sched& S, const Epi& E) {
    int tid_ = threadIdx.x; asm volatile("" : "+v"(tid_));
    const int tid = tid_, wid = __builtin_amdgcn_readfirstlane(tid >> 6), lane = tid & 63, wr = wid >> 2, wc = wid & 3, fr = lane & 15, fq = lane >> 4;
    const int nt = K / BK;
    const int lda = S.lda(), ldb = S.ldb();
    unsigned voffA[2], cvB[2], nvB[2];
    Unit cur, nxt; int ui = 0;
    if (!S.next(0, cur)) return;
#define PG8_VB(dst, u) do { _Pragma("unroll") for (int _i = 0; _i < 2; ++_i) { int R_, C_; stage_rc(tid * 16 + _i * 8192, R_, C_); const int Rb_ = Epi::PERM ? ((R_ & ~31) + perm32(R_ & 31)) : R_; \
        if constexpr (Sched::GATHER) dst[_i] = (unsigned)(S.btok(u, Rb_) * ldb + C_) * 2u; else dst[_i] = (unsigned)(Rb_ * ldb + C_) * 2u; } } while (0)
#pragma unroll
    for (int i = 0; i < 2; ++i) { int R, C; stage_rc(tid * 16 + i * 8192, R, C); voffA[i] = (unsigned)(R * lda + C) * 2u; }
    PG8_VB(cvB, cur);
    const size_t kstep = (size_t)(BK * 2);
    const size_t hstepA = (size_t)HALF * lda * 2;
    size_t chB, nhB;
    if constexpr (Sched::GATHER) chB = S.bhalf(cur); else chB = (size_t)HALF * ldb * 2;
    nhB = chB; nvB[0] = cvB[0]; nvB[1] = cvB[1];
    const unsigned ldsw = (unsigned)wid * 1024u;
    const int aoff = lds_byte(wr * 64 + fr, fq * 8), boff = lds_byte(wc * 32 + fr, fq * 8);
#define PG8_SA(b, h) (((b) * 2 + (h)) * HTB)
#define PG8_SB(b, h) ((4 + (b) * 2 + (h)) * HTB)
#define PG8_STAGE(bufoff, gbase, v0, v1) do { \
        __builtin_amdgcn_global_load_lds((const unsigned*)((const char*)(gbase) + (v0)), (PG8_LAS unsigned*)(lds + (bufoff) + ldsw), 16, 0, 0); \
        __builtin_amdgcn_global_load_lds((const unsigned*)((const char*)(gbase) + (v1)), (PG8_LAS unsigned*)(lds + (bufoff) + ldsw + 8192), 16, 0, 0); } while (0)
#define PG8_STA(bufoff, gbase) PG8_STAGE(bufoff, gbase, voffA[0], voffA[1])
#define PG8_LDA(dst, b, h) do { _Pragma("unroll") for (int m = 0; m < 4; ++m) _Pragma("unroll") for (int k = 0; k < 2; ++k) dst[m][k] = *(const PG8_LAS bf16x8*)(lds + PG8_SA(b, h) + aoff + m * 2048 + k * 1024); } while (0)
#define PG8_LDB(dst, b, h) do { _Pragma("unroll") for (int n = 0; n < 2; ++n) _Pragma("unroll") for (int k = 0; k < 2; ++k) dst[n][k] = *(const PG8_LAS bf16x8*)(lds + PG8_SB(b, h) + boff + n * 2048 + k * 1024); } while (0)
#define PG8_MMA(ai, bj, At, Bt) do { __builtin_amdgcn_s_setprio(1); _Pragma("unroll") for (int m = 0; m < 4; ++m) _Pragma("unroll") for (int n = 0; n < 2; ++n) _Pragma("unroll") for (int k = 0; k < 2; ++k) \
        acc[ai][bj][m][n] = __builtin_amdgcn_mfma_f32_16x16x32_bf16(Bt[n][k], At[m][k], acc[ai][bj][m][n], 0, 0, 0); __builtin_amdgcn_s_setprio(0); } while (0)
#define PG8_WAIT_V(n) asm volatile("s_waitcnt vmcnt(" #n ")" ::: "memory")
#define PG8_WAIT_L(n) asm volatile("s_waitcnt lgkmcnt(" #n ")" ::: "memory")
#define PG8_BAR __builtin_amdgcn_s_barrier()
#define PG8_SCHED __builtin_amdgcn_sched_barrier(0)
    f32x4 acc[2][2][4][2];
#pragma unroll
    for (int a = 0; a < 2; ++a)
#pragma unroll
        for (int b = 0; b < 2; ++b)
#pragma unroll
            for (int m = 0; m < 4; ++m)
#pragma unroll
                for (int n = 0; n < 2; ++n) acc[a][b][m][n] = (f32x4){0.f, 0.f, 0.f, 0.f};
    bf16x8 At[4][2], B0[2][2], B1[2][2];
    const char* cA = S.abase(cur); const char* cB = S.bbase(cur);
    PG8_STAGE(PG8_SB(0, 0), cB, cvB[0], cvB[1]); PG8_STAGE(PG8_SB(0, 1), cB + chB, cvB[0], cvB[1]); PG8_STA(PG8_SA(0, 0), cA); PG8_STA(PG8_SA(0, 1), cA + hstepA);
    if (wr == 1) PG8_BAR;
    PG8_WAIT_V(2); PG8_BAR;
    PG8_STAGE(PG8_SB(1, 0), cB + kstep, cvB[0], cvB[1]); PG8_STA(PG8_SA(1, 0), cA + kstep); PG8_STAGE(PG8_SB(1, 1), cB + chB + kstep, cvB[0], cvB[1]);
    PG8_WAIT_V(6); PG8_BAR;
    for (;;) {
        const bool has_next = S.next(ui + 1, nxt);
        const char* nA = has_next ? S.abase(nxt) : cA; const char* nB = has_next ? S.bbase(nxt) : cB;
        if constexpr (Sched::GATHER) { if (has_next) { PG8_VB(nvB, nxt); nhB = S.bhalf(nxt); } else { nvB[0] = cvB[0]; nvB[1] = cvB[1]; nhB = chB; } }
        for (int t = 0; t < nt; t += 2) {
            const bool last = (t == nt - 2);
            const char* a1 = cA + (size_t)(t + 1) * kstep;
            const char* a2 = last ? nA : cA + (size_t)(t + 2) * kstep; const char* b2 = last ? nB : cB + (size_t)(t + 2) * kstep;
            const char* a3 = a2 + kstep; const char* b3 = b2 + kstep;
            unsigned v20, v21; size_t h2;
            if constexpr (Sched::GATHER) { v20 = last ? nvB[0] : cvB[0]; v21 = last ? nvB[1] : cvB[1]; h2 = last ? nhB : chB; } else { v20 = cvB[0]; v21 = cvB[1]; h2 = chB; }
            PG8_LDB(B0, 0, 0); PG8_LDB(B1, 0, 1); PG8_SCHED; PG8_LDA(At, 0, 0); PG8_STA(PG8_SA(1, 1), a1 + hstepA);
            PG8_WAIT_V(8); PG8_WAIT_L(0); PG8_BAR; PG8_MMA(0, 0, At, B0); PG8_MMA(0, 1, At, B1); PG8_BAR; PG8_SCHED;
            PG8_LDA(At, 0, 1); PG8_STAGE(PG8_SB(0, 0), b2, v20, v21); PG8_STAGE(PG8_SB(0, 1), b2 + h2, v20, v21); PG8_STA(PG8_SA(0, 0), a2);
            PG8_WAIT_V(8); PG8_WAIT_L(0); PG8_BAR; PG8_MMA(1, 0, At, B0); PG8_MMA(1, 1, At, B1); PG8_BAR; PG8_SCHED;
            PG8_LDB(B0, 1, 0); PG8_LDB(B1, 1, 1); PG8_SCHED; PG8_LDA(At, 1, 0); PG8_STA(PG8_SA(0, 1), a2 + hstepA);
            PG8_WAIT_V(8); PG8_WAIT_L(0); PG8_BAR; PG8_MMA(0, 0, At, B0); PG8_MMA(0, 1, At, B1); PG8_BAR; PG8_SCHED;
            PG8_LDA(At, 1, 1); PG8_STAGE(PG8_SB(1, 0), b3, v20, v21); PG8_STAGE(PG8_SB(1, 1), b3 + h2, v20, v21); PG8_STA(PG8_SA(1, 0), a3);
            PG8_WAIT_V(8); PG8_WAIT_L(0); PG8_BAR; PG8_MMA(1, 0, At, B0); PG8_MMA(1, 1, At, B1); PG8_BAR; PG8_SCHED;
        }
        if (wr == 0) PG8_BAR;
        E(acc, cur, wr, wc, fr, fq);
        if (!has_next) break;
#pragma unroll
        for (int a = 0; a < 2; ++a)
#pragma unroll
            for (int b = 0; b < 2; ++b)
#pragma unroll
                for (int m = 0; m < 4; ++m)
#pragma unroll
                    for (int n = 0; n < 2; ++n) acc[a][b][m][n] = (f32x4){0.f, 0.f, 0.f, 0.f};
        cur = nxt; cA = nA; cB = nB; ++ui;
        if constexpr (Sched::GATHER) { cvB[0] = nvB[0]; cvB[1] = nvB[1]; chB = nhB; }
        if (wr == 1) PG8_BAR;
    }
    PG8_WAIT_V(0);
    PG8_BAR;
#undef PG8_VB
#undef PG8_SA
#undef PG8_SB
#undef PG8_STAGE
#undef PG8_STA
#undef PG8_LDA
#undef PG8_LDB
#undef PG8_MMA
#undef PG8_WAIT_V
#undef PG8_WAIT_L
#undef PG8_BAR
#undef PG8_SCHED
}
}

constexpr int NWAVES = 8;
constexpr int N_LAUNCHES = MK_N_LAUNCHES;
constexpr int N_PHASES = 14;
constexpr int BATCH = 4, SEQ = 8192, T = BATCH * SEQ, D = 1024, FF = 2752, FFP = 2816, NUP = 2 * FFP;
constexpr int NH = 12, HD = 128, AQ = NH * HD;
constexpr int FW = 512;
constexpr int NIN = 2 * AQ + 2 * D;
constexpr int NSW = AQ + 2 * FW;
constexpr float LN_EPS = 1e-5f;
constexpr float ALPHA = 1.18920711500272f;
constexpr float QSCALE = 0.08838834764831845f * 1.4426950408889634f;
constexpr float LOG2E = 1.4426950408889634f, LN2 = 0.6931471805599453f;

constexpr size_t MiB = 1u << 20;
constexpr size_t WS_CTL = 0, CTL_ZERO_BYTES = 1 * MiB;
constexpr size_t WS_W1A = 1 * MiB, WS_W1D = 12 * MiB, WS_W2A = 18 * MiB, WS_W2D = 29 * MiB, WS_WIN = 35 * MiB, WS_WSW = 45 * MiB, WS_WPA = 50 * MiB, WS_WPF = 51 * MiB, WS_WOUT = 52 * MiB;
constexpr size_t WS_TAB = 54 * MiB;
constexpr size_t TAB_BIASN = 0, TAB_BIASW = 32768, TAB_TBL = 65536, TAB_COS = 81920, TAB_SIN = 81920 + 32768, TAB_LSE = 1 * MiB;
constexpr size_t WS_XB = 58 * MiB;
constexpr size_t WS_BIG = 122 * MiB;
constexpr size_t WS_ACT = WS_BIG;
constexpr size_t WS_QB = WS_BIG, WS_KB = WS_BIG + 96 * MiB, WS_VT = WS_BIG + 192 * MiB;
constexpr size_t WS_ATT = WS_KB, WS_FOUR = WS_KB + 32 * MiB, WS_MRG = WS_KB + 64 * MiB, WS_YP = WS_KB + 128 * MiB;
constexpr size_t WS_Z1 = 410 * MiB, WS_END = 474 * MiB;
static_assert(WS_YP + 64 * MiB <= WS_Z1 && WS_MRG + 64 * MiB <= WS_YP && WS_ACT + (size_t)T * FFP * 2 <= WS_Z1, "d_ws map");
constexpr int CW_BAR = 4096;

constexpr int RING_OFF = 0, RING_BYTES = 131072;
constexpr int LDSCTL_OFF = RING_BYTES, MISC_OFF = LDSCTL_OFF + 320, LTAB_OFF = RING_BYTES + 1024;
constexpr int LDS_BYTES = 147456;

#define GAS __attribute__((address_space(1)))
#define LAS __attribute__((address_space(3)))
typedef unsigned short bf16;
typedef unsigned v4u __attribute__((ext_vector_type(4)));
typedef unsigned v2u __attribute__((ext_vector_type(2)));
typedef float f32x4 __attribute__((ext_vector_type(4)));
#define RLX_AGENT __ATOMIC_RELAXED, __HIP_MEMORY_SCOPE_AGENT
#define LDS_WAIT() asm volatile("s_waitcnt lgkmcnt(0)" ::: "memory")
#define VM_WAIT() asm volatile("s_waitcnt vmcnt(0)" ::: "memory")
__device__ __forceinline__ unsigned f2bf(float f) { unsigned u = __builtin_bit_cast(unsigned, f); return (u + 0x7fffu + ((u >> 16) & 1u)) >> 16; }
__device__ __forceinline__ unsigned pk2(float lo, float hi) { return f2bf(lo) | (f2bf(hi) << 16); }
__device__ __forceinline__ float bf2f(unsigned short h) { return __uint_as_float(((unsigned)h) << 16); }

#define XB_TMO      128
#define XB_XCNT(j)  (256  + 64 * (j))
#define XB_XSUB(j)  (1280 + 64 * (j))
#define XB_XGEN(j)  (2304 + 64 * (j))
#define XB_TOP      3328
#define XB_TOPGEN   3392
#define XCD_BAR_WORDS 3456
#define XB_SPIN_CAP (1u << 18)
__device__ __forceinline__ unsigned xb_ld(unsigned* p)              { return __hip_atomic_load(p, __ATOMIC_RELAXED, __HIP_MEMORY_SCOPE_AGENT); }
__device__ __forceinline__ unsigned xb_add(unsigned* p, unsigned v) { return __hip_atomic_fetch_add(p, v, __ATOMIC_RELAXED, __HIP_MEMORY_SCOPE_AGENT); }
__device__ __forceinline__ unsigned xb_xcc_id() { return (unsigned)__builtin_amdgcn_s_getreg((3 << 11) | 20) & 0xFu; }
#define XB_SPIN(cond, bar) do { unsigned _sp = 0; while (cond) { __builtin_amdgcn_s_sleep(1); \
    if ((++_sp & 255u) == 0u) { if (xb_ld(&(bar)[XB_TMO])) break; if (_sp > XB_SPIN_CAP) { atomicAdd(&(bar)[XB_TMO], 1u); break; } } } } while (0)
struct XcdBarrier { unsigned* bar; unsigned x; volatile LAS unsigned* st; };
__device__ __forceinline__ XcdBarrier xcd_barrier_post(unsigned* bar, volatile LAS unsigned* st) {
    XcdBarrier b; b.bar = bar; b.x = xb_xcc_id(); b.st = st;
    if (threadIdx.x == 0) (void)xb_add(&bar[XB_XCNT(b.x)], 1u);
    return b;
}
__device__ __forceinline__ void xcd_barrier_complete(unsigned* bar, unsigned x, unsigned& nloc, unsigned& nx) {
    const unsigned G = gridDim.x * gridDim.y * gridDim.z;
    unsigned sum, cnt, mine, sp = 0u;
    for (;;) {
        sum = 0u; cnt = 0u; mine = 0u;
#pragma unroll
        for (unsigned j = 0; j < 16; ++j) { const unsigned c = xb_ld(&bar[XB_XCNT(j)]); sum += c; cnt += (c > 0u) ? 1u : 0u; mine = (j == x) ? c : mine; }
        if (sum == G) break;
        __builtin_amdgcn_s_sleep(1);
        if ((++sp & 255u) == 0u) { if (xb_ld(&bar[XB_TMO])) break; if (sp > XB_SPIN_CAP) { atomicAdd(&bar[XB_TMO], 1u); break; } }
    }
    nloc = mine > 0u ? mine : 1u; nx = cnt > 0u ? cnt : 1u;
}
__device__ __forceinline__ void xcd_barrier(const XcdBarrier& b) {
    asm volatile("s_waitcnt vmcnt(0)" ::: "memory");
    __syncthreads();
    if (threadIdx.x == 0) {
        unsigned* bar = b.bar;
        __builtin_amdgcn_s_waitcnt(0);
        unsigned nloc = b.st[0], nx = b.st[1];
        if (nloc == 0u) { xcd_barrier_complete(bar, b.x, nloc, nx); b.st[0] = nloc; b.st[1] = nx; }
        const unsigned old = xb_add(&bar[XB_XSUB(b.x)], 1u);
        const unsigned gen = old / nloc;
        if (old + 1u == (gen + 1u) * nloc) {
            __builtin_amdgcn_fence(__ATOMIC_RELEASE, "agent");
            asm volatile("s_waitcnt vmcnt(0)" ::: "memory");
            const unsigned og = xb_add(&bar[XB_TOP], 1u);
            const unsigned tg = og / nx;
            if (og + 1u == (tg + 1u) * nx) xb_add(&bar[XB_TOPGEN], 1u);
            else XB_SPIN(xb_ld(&bar[XB_TOPGEN]) == tg, bar);
            __builtin_amdgcn_fence(__ATOMIC_ACQUIRE, "agent");
            xb_add(&bar[XB_XGEN(b.x)], 1u);
            asm volatile("s_waitcnt vmcnt(0)" ::: "memory");
        } else {
            XB_SPIN(xb_ld(&bar[XB_XGEN(b.x)]) == gen, bar);
            __builtin_amdgcn_fence(__ATOMIC_ACQUIRE, "agent");
            asm volatile("s_waitcnt vmcnt(0)" ::: "memory");
        }
    }
    __syncthreads();
}

struct SchedStd {
    static constexpr bool GATHER = false;
    const bf16* A; const bf16* Bt; int lda_, ldb_, nM, nN, G, c;
    __device__ __forceinline__ int lda() const { return lda_; }
    __device__ __forceinline__ int ldb() const { return ldb_; }
    __device__ __forceinline__ bool next(int i, pg8::Unit& u) const { const long L = (long)i * G + c; if (L >= (long)nM * nN) return false; pg8::tile_of((int)L, nM, nN, u.pm, u.pn); u.kind = 0; return true; }
    __device__ __forceinline__ const char* abase(const pg8::Unit& u) const { return (const char*)A + (size_t)u.pm * 256 * lda_ * 2; }
    __device__ __forceinline__ const char* bbase(const pg8::Unit& u) const { return (const char*)Bt + (size_t)u.pn * 256 * ldb_ * 2; }
    __device__ __forceinline__ int btok(const pg8::Unit&, int j) const { return j; }
    __device__ __forceinline__ size_t bhalf(const pg8::Unit&) const { return (size_t)128 * ldb_ * 2; }
};
struct SchedProj {
    static constexpr bool GATHER = false;
    const bf16* ATT; const bf16* WPA; int G, c;
    __device__ __forceinline__ int lda() const { return FW; }
    __device__ __forceinline__ int ldb() const { return FW; }
    __device__ __forceinline__ bool next(int i, pg8::Unit& u) const { const long L = (long)(i >> 1) * G + c; if (L >= (long)(T / 256) * (D / 256)) return false; pg8::tile_of((int)L, T / 256, D / 256, u.pm, u.pn); u.kind = i & 1; return true; }
    __device__ __forceinline__ const char* abase(const pg8::Unit& u) const { return (const char*)ATT + ((size_t)u.kind * T * FW + (size_t)u.pm * 256 * FW) * 2; }
    __device__ __forceinline__ const char* bbase(const pg8::Unit& u) const { return (const char*)WPA + ((size_t)u.kind * D * FW + (size_t)u.pn * 256 * FW) * 2; }
    __device__ __forceinline__ int btok(const pg8::Unit&, int j) const { return j; }
    __device__ __forceinline__ size_t bhalf(const pg8::Unit&) const { return (size_t)128 * FW * 2; }
};
__device__ __forceinline__ int swap23(int j) { return (j & ~12) | ((j & 4) << 1) | ((j & 8) >> 1); }
struct SchedSw {
    static constexpr bool GATHER = true;
    const bf16* WSW; const bf16* H1; int G, c;
    __device__ __forceinline__ int lda() const { return D; }
    __device__ __forceinline__ int ldb() const { return D; }
    __device__ __forceinline__ bool next(int i, pg8::Unit& u) const { const long L = (long)i * G + c; if (L >= (long)(NSW / 256) * (T / 256)) return false; pg8::tile_of((int)L, NSW / 256, T / 256, u.pm, u.pn); u.kind = 0; return true; }
    __device__ __forceinline__ const char* abase(const pg8::Unit& u) const { return (const char*)WSW + (size_t)u.pm * 256 * D * 2; }
    __device__ __forceinline__ const char* bbase(const pg8::Unit& u) const {
        const int b = u.pn >> 5, nb0 = (u.pn & 31) * 256; int tok0;
        if (u.pm < 6) { const int sh = 2 * (u.pm >> 1), L = SEQ >> sh, r = nb0 / L, mp0 = nb0 & (L - 1); tok0 = b * SEQ + (mp0 << sh) + r; }
        else tok0 = b * SEQ + (u.pn & 31) * 4;
        return (const char*)H1 + (size_t)tok0 * D * 2;
    }
    __device__ __forceinline__ int btok(const pg8::Unit& u, int j) const { return (u.pm < 6) ? (swap23(j) << (2 * (u.pm >> 1))) : (128 * (j & 63) + (j >> 6)); }
    __device__ __forceinline__ size_t bhalf(const pg8::Unit& u) const { return (u.pm < 6) ? ((size_t)(128 << (2 * (u.pm >> 1))) * D * 2) : ((size_t)2 * D * 2); }
};

using pg8::f32x2;
__device__ __forceinline__ float sigmoidf_(float v) { return __builtin_amdgcn_rcpf(1.0f + __builtin_amdgcn_exp2f(-1.4426950408889634f * v)); }
struct EpiSwiGLU {
    static constexpr bool PERM = true;
    bf16* O;
    __device__ __forceinline__ void operator()(const f32x4 (&acc)[2][2][4][2], const pg8::Unit& u, int wr, int wc, int fr, int fq) const {
        const int row0 = u.pm * 256 + wr * 64 + fr, col0 = u.pn * 128 + wc * 32 + 8 * fq;
#pragma unroll
        for (int ai = 0; ai < 2; ++ai)
#pragma unroll
            for (int m = 0; m < 4; ++m) {
                float o[8];
#pragma unroll
                for (int n = 0; n < 2; ++n)
#pragma unroll
                    for (int j = 0; j < 4; ++j) { const float g = acc[ai][0][m][n][j], up = acc[ai][1][m][n][j]; o[4 * n + j] = g * sigmoidf_(g) * up; }
                v4u w; w.x = pg8::cvt_pk_bf16(o[0], o[1]); w.y = pg8::cvt_pk_bf16(o[2], o[3]); w.z = pg8::cvt_pk_bf16(o[4], o[5]); w.w = pg8::cvt_pk_bf16(o[6], o[7]);
                *(v4u*)(O + (size_t)(row0 + ai * 128 + m * 16) * FFP + col0) = w; }
    }
};
struct EpiInproj {
    static constexpr bool PERM = true;
    bf16* QB; bf16* KB; bf16* GATES; const float* bias;
    __device__ __forceinline__ void operator()(const f32x4 (&acc)[2][2][4][2], const pg8::Unit& u, int wr, int wc, int fr, int fq) const {
        const int row0 = u.pm * 256 + wr * 64 + fr, cw = wc * 32 + 8 * fq;
        bf16* base; int ldc, mode;
        if (u.pn < 6) { base = QB + u.pn * 256; ldc = AQ; mode = 0; } else if (u.pn < 12) { base = KB + (u.pn - 6) * 256; ldc = AQ; mode = 1; } else { base = GATES + (u.pn - 12) * 256; ldc = 2 * D; mode = 2; }
        f32x4 bv[2][2];
#pragma unroll
        for (int bj = 0; bj < 2; ++bj)
#pragma unroll
            for (int n = 0; n < 2; ++n) bv[bj][n] = *(const f32x4*)(bias + u.pn * 256 + bj * 128 + cw + 4 * n);
#pragma unroll
        for (int ai = 0; ai < 2; ++ai)
#pragma unroll
            for (int m = 0; m < 4; ++m) { bf16* rowp = base + (size_t)(row0 + ai * 128 + m * 16) * ldc + cw;
#pragma unroll
                for (int bj = 0; bj < 2; ++bj) { f32x4 v0 = acc[ai][bj][m][0] + bv[bj][0], v1 = acc[ai][bj][m][1] + bv[bj][1];
                    if (mode == 0) { v0 = v0 * QSCALE; v1 = v1 * QSCALE; }
                    if (mode == 2) {
#pragma unroll
                        for (int j = 0; j < 4; ++j) { v0[j] = sigmoidf_(v0[j]); v1[j] = sigmoidf_(v1[j]); } }
                    v4u w; w.x = pg8::cvt_pk_bf16(v0[0], v0[1]); w.y = pg8::cvt_pk_bf16(v0[2], v0[3]); w.z = pg8::cvt_pk_bf16(v1[0], v1[1]); w.w = pg8::cvt_pk_bf16(v1[2], v1[3]);
                    *(v4u*)(rowp + bj * 128) = w; } }
    }
};
struct EpiSw {
    static constexpr bool PERM = true;
    bf16* VT; bf16* Z1; const float* bias;
    __device__ __forceinline__ void operator()(const f32x4 (&acc)[2][2][4][2], const pg8::Unit& u, int wr, int wc, int fr, int fq) const {
        const int r0 = u.pm * 256 + wr * 64 + fr, n0 = u.pn * 256 + wc * 32 + 8 * fq;
#pragma unroll
        for (int ai = 0; ai < 2; ++ai)
#pragma unroll
            for (int m = 0; m < 4; ++m) { const int R = r0 + ai * 128 + m * 16; const float bs = bias[R];
#pragma unroll
                for (int bj = 0; bj < 2; ++bj) { const int n = n0 + bj * 128; const f32x4 v0 = acc[ai][bj][m][0] + bs, v1 = acc[ai][bj][m][1] + bs;
                    v4u w; w.x = pg8::cvt_pk_bf16(v0[0], v0[1]); w.y = pg8::cvt_pk_bf16(v0[2], v0[3]); w.z = pg8::cvt_pk_bf16(v1[0], v1[1]); w.w = pg8::cvt_pk_bf16(v1[2], v1[3]);
                    bf16* p;
                    if (u.pm < 6) p = VT + ((size_t)((n >> 13) * AQ + R) * SEQ + (n & (SEQ - 1)));
                    else { const int zr = R - AQ, ri = zr >> 9, ch = zr & 511, b = n >> 13, s2 = (n >> 6) & 127, s1 = n & 63; p = Z1 + ((((size_t)(ch * 4 + b) * 128 + s2) * 2 + ri) * 64 + s1); }
                    *(v4u*)p = w; } }
    }
};
struct EpiDown {
    static constexpr bool PERM = false;
    const float* res; float* out;
    __device__ __forceinline__ void operator()(const f32x4 (&acc)[2][2][4][2], const pg8::Unit& u, int wr, int wc, int fr, int fq) const {
        const int row0 = u.pm * 256 + wr * 64 + fr, col0 = u.pn * 256 + wc * 32 + 4 * fq;
#pragma unroll
        for (int ai = 0; ai < 2; ++ai)
#pragma unroll
            for (int m = 0; m < 4; ++m) { const size_t off = (size_t)(row0 + ai * 128 + m * 16) * D + col0;
#pragma unroll
                for (int bj = 0; bj < 2; ++bj)
#pragma unroll
                    for (int n = 0; n < 2; ++n) { const f32x4 r = *(const f32x4*)(res + off + bj * 128 + n * 16); *(f32x4*)(out + off + bj * 128 + n * 16) = r * ALPHA + acc[ai][bj][m][n] * 0.5f; } }
    }
};
struct EpiWout {
    static constexpr bool PERM = false;
    const bf16* res; float* out;
    __device__ __forceinline__ void operator()(const f32x4 (&acc)[2][2][4][2], const pg8::Unit& u, int wr, int wc, int fr, int fq) const {
        const int row0 = u.pm * 256 + wr * 64 + fr, col0 = u.pn * 256 + wc * 32 + 4 * fq;
#pragma unroll
        for (int ai = 0; ai < 2; ++ai)
#pragma unroll
            for (int m = 0; m < 4; ++m) { const size_t off = (size_t)(row0 + ai * 128 + m * 16) * D + col0;
#pragma unroll
                for (int bj = 0; bj < 2; ++bj)
#pragma unroll
                    for (int n = 0; n < 2; ++n) { const v2u rw = *(const v2u*)(res + off + bj * 128 + n * 16);
                        const f32x4 r = (f32x4){pg8::bf_lo(rw.x), pg8::bf_hi(rw.x), pg8::bf_lo(rw.y), pg8::bf_hi(rw.y)};
                        *(f32x4*)(out + off + bj * 128 + n * 16) = r * ALPHA + acc[ai][bj][m][n]; } }
    }
};
struct EpiProj {
    static constexpr bool PERM = true;
    const bf16* GATES; bf16* MRG;
    __device__ __forceinline__ void operator()(const f32x4 (&acc)[2][2][4][2], const pg8::Unit& u, int wr, int wc, int fr, int fq) const {
        const int row0 = u.pm * 256 + wr * 64 + fr, col0 = u.pn * 256 + wc * 32 + 8 * fq;
#pragma unroll
        for (int ai = 0; ai < 2; ++ai)
#pragma unroll
            for (int m = 0; m < 4; ++m) { const int row = row0 + ai * 128 + m * 16;
#pragma unroll
                for (int bj = 0; bj < 2; ++bj) { const int col = col0 + bj * 128;
                    const v4u gw = *(const v4u*)(GATES + (size_t)row * (2 * D) + u.kind * D + col);
                    float o[8]; const f32x4 a0 = acc[ai][bj][m][0], a1 = acc[ai][bj][m][1];
                    o[0] = pg8::bf_lo(gw.x) * a0[0]; o[1] = pg8::bf_hi(gw.x) * a0[1]; o[2] = pg8::bf_lo(gw.y) * a0[2]; o[3] = pg8::bf_hi(gw.y) * a0[3];
                    o[4] = pg8::bf_lo(gw.z) * a1[0]; o[5] = pg8::bf_hi(gw.z) * a1[1]; o[6] = pg8::bf_lo(gw.w) * a1[2]; o[7] = pg8::bf_hi(gw.w) * a1[3];
                    bf16* p = MRG + (size_t)row * D + col;
                    if (u.kind == 1) {
                        const unsigned long long q0 = __hip_atomic_load((const unsigned long long*)p, RLX_AGENT), q1 = __hip_atomic_load((const unsigned long long*)p + 1, RLX_AGENT);
                        const unsigned w0 = (unsigned)q0, w1 = (unsigned)(q0 >> 32), w2 = (unsigned)q1, w3 = (unsigned)(q1 >> 32);
                        o[0] += pg8::bf_lo(w0); o[1] += pg8::bf_hi(w0); o[2] += pg8::bf_lo(w1); o[3] += pg8::bf_hi(w1); o[4] += pg8::bf_lo(w2); o[5] += pg8::bf_hi(w2); o[6] += pg8::bf_lo(w3); o[7] += pg8::bf_hi(w3); }
                    v4u w; w.x = pg8::cvt_pk_bf16(o[0], o[1]); w.y = pg8::cvt_pk_bf16(o[2], o[3]); w.z = pg8::cvt_pk_bf16(o[4], o[5]); w.w = pg8::cvt_pk_bf16(o[6], o[7]);
                    *(v4u*)p = w; } }
    }
};

struct Ctx { LAS unsigned char* lds; int tid, lane, wave, G, gw, NGW; };
__device__ __forceinline__ float wave_sum(float v) {
#pragma unroll
    for (int o = 1; o < 64; o <<= 1) v += __shfl_xor(v, o);
    return v;
}
template <class RowMap>
__device__ __forceinline__ void tr_item(const float* W, int ldw, int k0, int n0, bf16* WT, int ldt, const RowMap& rm, LAS float* scr, int lane) {
#pragma unroll 8
    for (int i = 0; i < 32; ++i) { const int kk = 2 * i + (lane >> 5); scr[kk * 33 + (lane & 31)] = W[(size_t)(k0 + kk) * ldw + n0 + (lane & 31)]; }
    LDS_WAIT(); asm volatile("" ::: "memory");
    const int c = lane & 7;
#pragma unroll
    for (int j = 0; j < 4; ++j) { const int n = (lane >> 3) + 8 * j; const LAS float* s = scr + (8 * c) * 33 + n;
        v4u o; o.x = pk2(s[0 * 33], s[1 * 33]); o.y = pk2(s[2 * 33], s[3 * 33]); o.z = pk2(s[4 * 33], s[5 * 33]); o.w = pk2(s[6 * 33], s[7 * 33]);
        *(GAS v4u*)(WT + (size_t)rm(n0 + n) * ldt + k0 + 8 * c) = o; }
    LDS_WAIT(); asm volatile("" ::: "memory");
}
template <class RowMap>
__device__ __forceinline__ void tr_matrix(const Ctx& C, const float* W, int ldw, int K, int ncol0, int ncols, bf16* WT, int ldt, const RowMap& rm) {
    LAS float* scr = (LAS float*)(C.lds + RING_OFF + C.wave * 16384);
    const int nblk = ncols / 32, nitems = (K / 64) * nblk;
    for (int it = C.gw; it < nitems; it += C.NGW) { const int kb = it / nblk, nb = it % nblk; tr_item(W, ldw, 64 * kb, ncol0 + 32 * nb, WT, ldt, rm, scr, C.lane); }
}
struct RmOff { int off; __device__ __forceinline__ int operator()(int n) const { return n + off; } };
struct RmGU { int up; __device__ __forceinline__ int operator()(int n) const { return (n >> 7) * 256 + (n & 127) + up; } };

struct Inputs { const float *x, *ln1g, *ln1b, *w1g, *w1u, *w1d, *win, *bin, *relb, *wpa, *wpf, *wout, *ln2g, *ln2b, *w2g, *w2u, *w2d, *ln3g, *ln3b; };

__device__ __forceinline__ int t5_bucket(int rel) {
    const int ret = rel > 0 ? 16 : 0; const int n = rel < 0 ? -rel : rel;
    const float nf = (float)(n > 1 ? n : 1);
    int large = 8 + (int)(logf(nf / 8.0f) / 4.852030263919617f * 8.0f);
    large = large < 15 ? large : 15;
    return ret + (n < 8 ? n : large);
}

__device__ __forceinline__ void p0_prologue(const Ctx& C, const Inputs& I, unsigned char* ws) {
    bf16* W1A = (bf16*)(ws + WS_W1A); bf16* W1D = (bf16*)(ws + WS_W1D); bf16* W2A = (bf16*)(ws + WS_W2A); bf16* W2D = (bf16*)(ws + WS_W2D);
    bf16* WIN = (bf16*)(ws + WS_WIN); bf16* WSW = (bf16*)(ws + WS_WSW); bf16* WPA = (bf16*)(ws + WS_WPA); bf16* WPF = (bf16*)(ws + WS_WPF); bf16* WOUT = (bf16*)(ws + WS_WOUT);
    float* BIASN = (float*)(ws + WS_TAB + TAB_BIASN); float* BIASW = (float*)(ws + WS_TAB + TAB_BIASW); float* TBL = (float*)(ws + WS_TAB + TAB_TBL);
    float* COS = (float*)(ws + WS_TAB + TAB_COS); float* SIN = (float*)(ws + WS_TAB + TAB_SIN);
    bf16* XB = (bf16*)(ws + WS_XB);
    LAS float* lc = (LAS float*)(C.lds + LTAB_OFF); LAS float* ls = lc + 128;
    if (C.tid < 128) { lc[C.tid] = cospif((float)C.tid / 64.0f); ls[C.tid] = sinpif((float)C.tid / 64.0f); }
    __syncthreads();
    tr_matrix(C, I.w1g, FF, D, 0, FF, W1A, D, RmGU{0});   tr_matrix(C, I.w1u, FF, D, 0, FF, W1A, D, RmGU{128});
    tr_matrix(C, I.w2g, FF, D, 0, FF, W2A, D, RmGU{0});   tr_matrix(C, I.w2u, FF, D, 0, FF, W2A, D, RmGU{128});
    tr_matrix(C, I.w1d, D, FF, 0, D, W1D, FFP, RmOff{0}); tr_matrix(C, I.w2d, D, FF, 0, D, W2D, FFP, RmOff{0});
    tr_matrix(C, I.win, 7168, D, 0, AQ, WIN, D, RmOff{0});
    tr_matrix(C, I.win, 7168, D, AQ, AQ, WIN, D, RmOff{0});
    tr_matrix(C, I.win, 7168, D, 3 * AQ + FW, 2 * D, WIN, D, RmOff{2 * AQ - (3 * AQ + FW)});
    tr_matrix(C, I.win, 7168, D, 2 * AQ, AQ, WSW, D, RmOff{-2 * AQ});
    tr_matrix(C, I.wpa, D, FW, 0, D, WPA, FW, RmOff{0}); tr_matrix(C, I.wpf, D, FW, 0, D, WPF, FW, RmOff{0}); tr_matrix(C, I.wout, D, D, 0, D, WOUT, D, RmOff{0});
    const int gt = C.gw * 64 + C.lane, NGT = C.NGW * 64;
    for (int i = gt; i < 2 * 128 * (D / 8); i += NGT) { const int w = i / (128 * (D / 8)), r = (i / (D / 8)) % 128, c8 = i % (D / 8); const int row = 21 * 256 + 64 + (r & 63) + (r >> 6) * 128;
        *(v4u*)((w ? W2A : W1A) + (size_t)row * D + c8 * 8) = (v4u){0u, 0u, 0u, 0u}; }
    for (int i = gt; i < 2 * D * 8; i += NGT) { const int w = i / (D * 8), r = (i / 8) % D, c8 = i % 8; *(v4u*)((w ? W2D : W1D) + (size_t)r * FFP + FF + c8 * 8) = (v4u){0u, 0u, 0u, 0u}; }
    { LAS float* scr = (LAS float*)(C.lds + RING_OFF + C.wave * 16384);
      for (int it = C.gw; it < D * 4; it += C.NGW) { const int k = it >> 2, g = it & 3;
          const float* src = I.win + (size_t)k * 7168 + 3 * AQ + g * 128;
          scr[C.lane] = src[C.lane]; scr[C.lane + 64] = src[C.lane + 64];
          LDS_WAIT(); asm volatile("" ::: "memory");
          float ar0 = 0.f, ai0 = 0.f, ar1 = 0.f, ai1 = 0.f;
          for (int c = 0; c < 128; ++c) { const float w = scr[c]; const int i0 = (c * C.lane) & 127, i1 = (c * (C.lane + 64)) & 127;
              ar0 += w * lc[i0]; ai0 -= w * ls[i0]; ar1 += w * lc[i1]; ai1 -= w * ls[i1]; }
          WSW[(size_t)(AQ + g * 128 + C.lane) * D + k] = (bf16)f2bf(ar0);        WSW[(size_t)(AQ + g * 128 + C.lane + 64) * D + k] = (bf16)f2bf(ar1);
          WSW[(size_t)(AQ + 512 + g * 128 + C.lane) * D + k] = (bf16)f2bf(ai0);  WSW[(size_t)(AQ + 512 + g * 128 + C.lane + 64) * D + k] = (bf16)f2bf(ai1);
          LDS_WAIT(); asm volatile("" ::: "memory"); } }
    for (int i = gt; i < NIN; i += NGT) BIASN[i] = I.bin[i < 2 * AQ ? i : i + AQ + FW];
    for (int i = gt; i < NSW; i += NGT) {
        if (i < AQ) BIASW[i] = I.bin[2 * AQ + i];
        else { const int z = i - AQ, ri = z >> 9, g = (z >> 7) & 3, cp = z & 127; float a = 0.f;
            for (int c = 0; c < 128; ++c) { const int ix = (c * cp) & 127; a += I.bin[3 * AQ + g * 128 + c] * (ri ? -ls[ix] : lc[ix]); }
            BIASW[i] = a; } }
    for (int i = gt; i < NH * 129; i += NGT) { const int hd = i / 129, off = i % 129 - 64, dil = 1 << (2 * (hd >> 2)); TBL[i] = I.relb[t5_bucket(off * dil) * NH + hd]; }
    for (int i = gt; i < 8192; i += NGT) { COS[i] = cospif((float)i / 4096.0f); SIN[i] = sinpif((float)i / 4096.0f); }
    for (int m = C.gw; m < T; m += C.NGW) { const GAS f32x4* xr = (const GAS f32x4*)(I.x + (size_t)m * D) + C.lane; GAS unsigned long long* o8 = (GAS unsigned long long*)(XB + (size_t)m * D) + C.lane;
#pragma unroll
        for (int j = 0; j < 4; ++j) { const f32x4 v = xr[64 * j]; o8[64 * j] = (unsigned long long)pk2(v.x, v.y) | ((unsigned long long)pk2(v.z, v.w) << 32); } }
}

__device__ __forceinline__ void ln_pass(const Ctx& C, const float* v, float* outf, bf16* outb, const float* g, const float* b) {
    f32x4 gv[4], bv[4];
#pragma unroll
    for (int j = 0; j < 4; ++j) { gv[j] = *((const f32x4*)g + C.lane + 64 * j); bv[j] = *((const f32x4*)b + C.lane + 64 * j); }
    for (int m = C.gw; m < T; m += C.NGW) {
        const f32x4* xr = (const f32x4*)(v + (size_t)m * D) + C.lane;
        f32x4 x[4]; float s = 0.f;
#pragma unroll
        for (int j = 0; j < 4; ++j) { x[j] = xr[64 * j]; s += (x[j].x + x[j].y) + (x[j].z + x[j].w); }
        const float mean = wave_sum(s) * (1.f / D); float s2 = 0.f;
#pragma unroll
        for (int j = 0; j < 4; ++j) { x[j] = x[j] - mean; s2 += (x[j].x * x[j].x + x[j].y * x[j].y) + (x[j].z * x[j].z + x[j].w * x[j].w); }
        const float rstd = 1.f / sqrtf(wave_sum(s2) * (1.f / D) + LN_EPS);
#pragma unroll
        for (int j = 0; j < 4; ++j) { const f32x4 y = x[j] * rstd * gv[j] + bv[j];
            if (outf) *((f32x4*)(outf + (size_t)m * D) + C.lane + 64 * j) = y;
            if (outb) *((unsigned long long*)(outb + (size_t)m * D) + C.lane + 64 * j) = (unsigned long long)pk2(y.x, y.y) | ((unsigned long long)pk2(y.z, y.w) << 32); }
    }
}

#ifdef MK_SIMPLE
__device__ __forceinline__ void attn_simple(const Ctx& C, bf16* QB, const bf16* KB, const bf16* VT, float* LSE, const float* TBL) {
    LAS float* slog = (LAS float*)(C.lds + RING_OFF + C.wave * 1024);
    for (int it = C.gw; it < T * NH; it += C.NGW) {
        const int tok = it / NH, hd = it % NH, g = hd >> 2, sh = 2 * g, L = SEQ >> sh, b = tok >> 13, s = tok & (SEQ - 1), r = s & ((1 << sh) - 1), m = s >> sh;
        const unsigned qw = *(const unsigned*)(QB + (size_t)tok * AQ + hd * HD + 2 * C.lane);
        const float q0 = pg8::bf_lo(qw), q1 = pg8::bf_hi(qw);
        float mx = -3.0e38f;
        for (int j = -64; j <= 64; ++j) { const int mk = m + j; float lg = -1e30f;
            if (mk >= 0 && mk < L) { const int kt = b * SEQ + (mk << sh) + r; const unsigned kw = *(const unsigned*)(KB + (size_t)kt * AQ + hd * HD + 2 * C.lane);
                lg = wave_sum(q0 * pg8::bf_lo(kw) + q1 * pg8::bf_hi(kw)) + TBL[hd * 129 + j + 64] * LOG2E; }
            if (C.lane == 0) slog[j + 64] = lg;
            mx = fmaxf(mx, lg); }
        LDS_WAIT(); asm volatile("" ::: "memory");
        float den = 0.f, o0 = 0.f, o1 = 0.f;
        const bf16* vrow = VT + ((size_t)(b * AQ + hd * HD + 2 * C.lane) * SEQ + r * L);
        for (int j = -64; j <= 64; ++j) { const int mk = m + j;
            if (mk >= 0 && mk < L) { const float p = exp2f(slog[j + 64] - mx); den += p; const int pos = swap23(mk);
                o0 += p * bf2f(vrow[pos]); o1 += p * bf2f(vrow[SEQ + pos]); } }
        const float inv = 1.0f / den;
        *(unsigned*)(QB + (size_t)tok * AQ + hd * HD + 2 * C.lane) = pk2(o0 * inv, o1 * inv);
        if (C.lane == 0) LSE[(size_t)tok * NH + hd] = (mx + log2f(den)) * LN2;
        LDS_WAIT(); asm volatile("" ::: "memory");
    }
}
__device__ __forceinline__ void combine_simple(const Ctx& C, const bf16* QB, const float* LSE, bf16* ATT) {
    for (int tok = C.gw; tok < T; tok += C.NGW) {
#pragma unroll
        for (int h = 0; h < 4; ++h) {
            const float l0 = LSE[(size_t)tok * NH + h], l1 = LSE[(size_t)tok * NH + 4 + h], l2 = LSE[(size_t)tok * NH + 8 + h];
            const float mx = fmaxf(l0, fmaxf(l1, l2)); float w0 = __expf(l0 - mx), w1 = __expf(l1 - mx), w2 = __expf(l2 - mx); const float inv = 1.0f / (w0 + w1 + w2); w0 *= inv; w1 *= inv; w2 *= inv;
            const unsigned a = *(const unsigned*)(QB + (size_t)tok * AQ + h * HD + 2 * C.lane), bq = *(const unsigned*)(QB + (size_t)tok * AQ + (4 + h) * HD + 2 * C.lane), c = *(const unsigned*)(QB + (size_t)tok * AQ + (8 + h) * HD + 2 * C.lane);
            *(unsigned*)(ATT + (size_t)tok * FW + h * HD + 2 * C.lane) = pk2(w0 * pg8::bf_lo(a) + w1 * pg8::bf_lo(bq) + w2 * pg8::bf_lo(c), w0 * pg8::bf_hi(a) + w1 * pg8::bf_hi(bq) + w2 * pg8::bf_hi(c));
        }
    }
}
__device__ __forceinline__ void fft1_simple(const Ctx& C, const bf16* Z1, bf16* YP, const float* COS, const float* SIN) {
    for (int it = C.gw; it < FW * BATCH * 128; it += C.NGW) {
        const int s2 = it & 127, cb = it >> 7, k1 = C.lane;
        const bf16* z = Z1 + (size_t)it * 128;
        float yr = 0.f, yi = 0.f;
        for (int s1 = 0; s1 < 64; ++s1) { const float zr = bf2f(z[s1]), zi = bf2f(z[64 + s1]); const int ix = ((s1 * k1) & 63) * 128; const float c = COS[ix], s = SIN[ix];
            yr += zr * c + zi * s; yi += zi * c - zr * s; }
        const int ix2 = s2 * k1; const float c2 = COS[ix2], sn2 = SIN[ix2];
        const float pr = yr * c2 + yi * sn2, pi = yi * c2 - yr * sn2;
        bf16* o = YP + ((size_t)(cb * 64 + k1) * 2) * 128 + s2;
        o[0] = (bf16)f2bf(pr); o[128] = (bf16)f2bf(pi);
    }
}
__device__ __forceinline__ void fft2_simple(const Ctx& C, const bf16* YP, bf16* FOUR, const float* COS, const float* SIN) {
    for (int it = C.gw; it < BATCH * 64 * FW; it += C.NGW) {
        const int ch = it & 511, k1 = (it >> 9) & 63, b = it >> 15;
        const bf16* y = YP + ((size_t)((ch * 4 + b) * 64 + k1) * 2) * 128;
        float a0 = 0.f, a1 = 0.f;
        for (int s2 = 0; s2 < 128; ++s2) { const float yr = bf2f(y[s2]), yi = bf2f(y[128 + s2]); const int i0 = ((s2 * C.lane) & 127) * 64, i1 = ((s2 * (C.lane + 64)) & 127) * 64;
            a0 += yr * COS[i0] + yi * SIN[i0]; a1 += yr * COS[i1] + yi * SIN[i1]; }
        FOUR[(size_t)(b * SEQ + k1 + 64 * C.lane) * FW + ch] = (bf16)f2bf(a0 * (1.0f / 1024.0f));
        FOUR[(size_t)(b * SEQ + k1 + 64 * (C.lane + 64)) * FW + ch] = (bf16)f2bf(a1 * (1.0f / 1024.0f));
    }
}
#endif

typedef float f32x16 __attribute__((ext_vector_type(16)));
typedef short bf16x8 __attribute__((ext_vector_type(8)));
__device__ __forceinline__ bf16x8 pack8(float a0, float a1, float a2, float a3, float a4, float a5, float a6, float a7) {
    v4u w; w.x = pg8::cvt_pk_bf16(a0, a1); w.y = pg8::cvt_pk_bf16(a2, a3); w.z = pg8::cvt_pk_bf16(a4, a5); w.w = pg8::cvt_pk_bf16(a6, a7); return __builtin_bit_cast(bf16x8, w);
}
__device__ __forceinline__ void attn_mfma(const Ctx& C, bf16* QB, const bf16* KB, const bf16* VT, float* LSE, const float* TBL, const bool dry) {
    LAS float* ltbl = (LAS float*)(C.lds + RING_OFF);
    for (int i = C.tid; i < NH * 129; i += NWAVES * 64) ltbl[i] = TBL[i] * LOG2E;
    __syncthreads();
    const int r32 = C.lane & 31, h = C.lane >> 5;
#define AT_SB() __builtin_amdgcn_sched_barrier(0)
    for (int wu = C.gw; wu < T * NH / 32; wu += C.NGW) {
        const int bh = wu >> 8, w256 = wu & 255, b = bh / NH, hd = bh % NH, sh = 2 * (hd >> 2), L = SEQ >> sh, nq = L >> 5, r = w256 / nq, q0 = (w256 % nq) * 32;
        const size_t qtok = (size_t)b * SEQ + ((size_t)(q0 + r32) << sh) + r;
        const bf16* qp = QB + qtok * AQ + hd * HD + 8 * h;
        const bf16* kbase = KB + ((size_t)b * SEQ + r) * AQ + hd * HD + 8 * h;
        const bf16* vbase = VT + ((size_t)(b * AQ + hd * HD + r32) * SEQ + (size_t)r * L + 8 * h);
        const LAS float* tb = ltbl + hd * 129 + 64 - r32;
        bf16x8 qf[8], bA[8], bB[8], bC[8];
        f32x16 S[5];
#define AT_TS(t) ((q0 - 64 + 32 * (t)) < 0 ? 0 : ((q0 - 64 + 32 * (t)) >= L ? L - 32 : (q0 - 64 + 32 * (t))))
#define AT_KLOAD(buf, t) do { const bf16* kp_ = kbase + ((size_t)(AT_TS(t) + r32) << sh) * AQ; _Pragma("unroll") for (int ks = 0; ks < 8; ++ks) buf[ks] = *(const bf16x8*)(kp_ + 16 * ks); } while (0)
#define AT_VLOAD(buf, t) do { const bf16* vp_ = vbase + AT_TS(t); _Pragma("unroll") for (int s_ = 0; s_ < 2; ++s_) _Pragma("unroll") for (int db = 0; db < 4; ++db) buf[s_ * 4 + db] = *(const bf16x8*)(vp_ + (size_t)(db * 32) * SEQ + 16 * s_); } while (0)
#define AT_SCOMP(t, buf) do { const int ts_ = q0 - 64 + 32 * (t); const bool ok_ = (ts_ >= 0 && ts_ < L); \
            _Pragma("unroll") for (int i = 0; i < 16; ++i) { const int kr = (i & 3) + 8 * (i >> 2) + 4 * h; const int off = 32 * (t) + kr - 64 - r32; float v = tb[32 * (t) + kr - 64]; \
                if ((t) == 0) v = (off >= -64) ? v : -1e30f; if ((t) == 4) v = (off <= 64) ? v : -1e30f; S[t][i] = ok_ ? v : -1e30f; } \
            _Pragma("unroll") for (int ks = 0; ks < 8; ++ks) S[t] = __builtin_amdgcn_mfma_f32_32x32x16_bf16(buf[ks], qf[ks], S[t], 0, 0, 0); } while (0)
#define AT_PV(t, buf) do { _Pragma("unroll") for (int s_ = 0; s_ < 2; ++s_) { \
            _Pragma("unroll") for (int db = 0; db < 4; ++db) o[db] = __builtin_amdgcn_mfma_f32_32x32x16_bf16(buf[s_ * 4 + db], P[t][s_], o[db], 0, 0, 0); } } while (0)
#pragma unroll
        for (int ks = 0; ks < 8; ++ks) qf[ks] = *(const bf16x8*)(qp + 16 * ks);
        AT_KLOAD(bA, 0); AT_KLOAD(bB, 1); AT_KLOAD(bC, 2); AT_SB();
        AT_SCOMP(0, bA); AT_SB(); AT_KLOAD(bA, 3); AT_SB();
        AT_SCOMP(1, bB); AT_SB(); AT_KLOAD(bB, 4); AT_SB();
        AT_SCOMP(2, bC); AT_SB(); AT_VLOAD(bC, 0); AT_SB();
        AT_SCOMP(3, bA); AT_SB(); AT_VLOAD(bA, 1); AT_SB();
        AT_SCOMP(4, bB); AT_SB(); AT_VLOAD(bB, 2); AT_SB();
        float mx = -3.0e38f;
#pragma unroll
        for (int t = 0; t < 5; ++t)
#pragma unroll
            for (int i = 0; i < 16; ++i) mx = fmaxf(mx, S[t][i]);
        mx = fmaxf(mx, __shfl_xor(mx, 32));
        float den = 0.f;
#pragma unroll
        for (int t = 0; t < 5; ++t)
#pragma unroll
            for (int i = 0; i < 16; ++i) { const float p = __builtin_amdgcn_exp2f(S[t][i] - mx); S[t][i] = p; den += p; }
        den += __shfl_xor(den, 32);
        bf16x8 P[5][2];
#pragma unroll
        for (int t = 0; t < 5; ++t)
#pragma unroll
            for (int s_ = 0; s_ < 2; ++s_) P[t][s_] = pack8(S[t][8 * s_], S[t][8 * s_ + 1], S[t][8 * s_ + 2], S[t][8 * s_ + 3], S[t][8 * s_ + 4], S[t][8 * s_ + 5], S[t][8 * s_ + 6], S[t][8 * s_ + 7]);
        f32x16 o[4];
#pragma unroll
        for (int db = 0; db < 4; ++db)
#pragma unroll
            for (int i = 0; i < 16; ++i) o[db][i] = 0.f;
        AT_SB();
        AT_PV(0, bC); AT_SB(); AT_VLOAD(bC, 3); AT_SB();
        AT_PV(1, bA); AT_SB(); AT_VLOAD(bA, 4); AT_SB();
        AT_PV(2, bB); AT_SB();
        AT_PV(3, bC); AT_SB();
        AT_PV(4, bA); AT_SB();
        const float inv = 1.0f / den;
        bf16* op = QB + qtok * AQ + hd * HD + 4 * h;
        if (!dry)
#pragma unroll
        for (int db = 0; db < 4; ++db)
#pragma unroll
            for (int i4 = 0; i4 < 4; ++i4) { v2u w; w.x = pg8::cvt_pk_bf16(o[db][4 * i4] * inv, o[db][4 * i4 + 1] * inv); w.y = pg8::cvt_pk_bf16(o[db][4 * i4 + 2] * inv, o[db][4 * i4 + 3] * inv);
                *(v2u*)(op + db * 32 + 8 * i4) = w; }
        if (h == 0 && !dry) LSE[qtok * NH + hd] = (mx + __builtin_amdgcn_logf(den)) * LN2;
    }
#undef AT_SB
#undef AT_TS
#undef AT_KLOAD
#undef AT_VLOAD
#undef AT_SCOMP
#undef AT_PV
    __syncthreads();
}
__device__ __forceinline__ void combine_vec(const Ctx& C, const bf16* QB, const float* LSE, bf16* ATT) {
    const int h = C.lane >> 4, d0 = (C.lane & 15) * 8;
    for (int tok = C.gw; tok < T; tok += C.NGW) {
        const float l0 = LSE[(size_t)tok * NH + h], l1 = LSE[(size_t)tok * NH + 4 + h], l2 = LSE[(size_t)tok * NH + 8 + h];
        const float mx = fmaxf(l0, fmaxf(l1, l2)); float w0 = __expf(l0 - mx), w1 = __expf(l1 - mx), w2 = __expf(l2 - mx); const float inv = 1.0f / (w0 + w1 + w2); w0 *= inv; w1 *= inv; w2 *= inv;
        const bf16* qp = QB + (size_t)tok * AQ + h * HD + d0;
        const v4u a = *(const v4u*)qp, bq = *(const v4u*)(qp + 4 * HD), c = *(const v4u*)(qp + 8 * HD);
        v4u o;
        o.x = pg8::cvt_pk_bf16(w0 * pg8::bf_lo(a.x) + w1 * pg8::bf_lo(bq.x) + w2 * pg8::bf_lo(c.x), w0 * pg8::bf_hi(a.x) + w1 * pg8::bf_hi(bq.x) + w2 * pg8::bf_hi(c.x));
        o.y = pg8::cvt_pk_bf16(w0 * pg8::bf_lo(a.y) + w1 * pg8::bf_lo(bq.y) + w2 * pg8::bf_lo(c.y), w0 * pg8::bf_hi(a.y) + w1 * pg8::bf_hi(bq.y) + w2 * pg8::bf_hi(c.y));
        o.z = pg8::cvt_pk_bf16(w0 * pg8::bf_lo(a.z) + w1 * pg8::bf_lo(bq.z) + w2 * pg8::bf_lo(c.z), w0 * pg8::bf_hi(a.z) + w1 * pg8::bf_hi(bq.z) + w2 * pg8::bf_hi(c.z));
        o.w = pg8::cvt_pk_bf16(w0 * pg8::bf_lo(a.w) + w1 * pg8::bf_lo(bq.w) + w2 * pg8::bf_lo(c.w), w0 * pg8::bf_hi(a.w) + w1 * pg8::bf_hi(bq.w) + w2 * pg8::bf_hi(c.w));
        *(v4u*)(ATT + (size_t)tok * FW + h * HD + d0) = o;
    }
}
constexpr int F1_LD = 136, F2_LD = 264;
__device__ __forceinline__ void fft1_mfma(const Ctx& C, const bf16* Z1, bf16* YP, const float* COS, const float* SIN) {
    LAS bf16* F1 = (LAS bf16*)(C.lds + RING_OFF);
    for (int idx = C.tid; idx < 128 * 128; idx += NWAVES * 64) { const int m = idx >> 7, k = idx & 127, k1 = m & 63, ri = m >> 6, s1 = k & 63, part = k >> 6, ix = ((s1 * k1) & 63) * 128;
        const float c = COS[ix], s = SIN[ix]; const float val = (ri == 0) ? (part == 0 ? c : s) : (part == 0 ? -s : c); F1[m * F1_LD + k] = (bf16)f2bf(val); }
    __syncthreads();
    const int r32 = C.lane & 31, h = C.lane >> 5;
    for (int wu = C.gw; wu < FW * BATCH * 128 / 32; wu += C.NGW) {
        const int n = wu * 32 + r32;
        const bf16* zp = Z1 + (size_t)n * 128 + 8 * h;
        bf16x8 bfr[8];
#pragma unroll
        for (int ks = 0; ks < 8; ++ks) bfr[ks] = *(const bf16x8*)(zp + 16 * ks);
        f32x16 acc[4];
#pragma unroll
        for (int mb = 0; mb < 4; ++mb)
#pragma unroll
            for (int i = 0; i < 16; ++i) acc[mb][i] = 0.f;
#pragma unroll
        for (int ks = 0; ks < 8; ++ks) {
#pragma unroll
            for (int mb = 0; mb < 4; ++mb) { const bf16x8 af = *(const LAS bf16x8*)(F1 + (mb * 32 + r32) * F1_LD + 16 * ks + 8 * h); acc[mb] = __builtin_amdgcn_mfma_f32_32x32x16_bf16(af, bfr[ks], acc[mb], 0, 0, 0); }
            if (ks & 1) __builtin_amdgcn_sched_barrier(0); }
        const int s2 = n & 127, cb = n >> 7;
#pragma unroll
        for (int mb = 0; mb < 2; ++mb)
#pragma unroll
            for (int i = 0; i < 16; ++i) { const int k1 = mb * 32 + (i & 3) + 8 * (i >> 2) + 4 * h; const float yr = acc[mb][i], yi = acc[mb + 2][i];
                const float x = (float)(s2 * k1) * (1.0f / 8192.0f); const float c2 = __builtin_amdgcn_cosf(x), sn = __builtin_amdgcn_sinf(x);
                bf16* o = YP + ((size_t)(cb * 64 + k1) * 2) * 128 + s2;
                o[0] = (bf16)f2bf(yr * c2 + yi * sn); o[128] = (bf16)f2bf(yi * c2 - yr * sn); }
    }
    __syncthreads();
}
__device__ __forceinline__ void fft2_mfma(const Ctx& C, const bf16* YP, bf16* FOUR, const float* COS, const float* SIN) {
    LAS bf16* F2 = (LAS bf16*)(C.lds + RING_OFF);
    for (int idx = C.tid; idx < 128 * 256; idx += NWAVES * 64) { const int k2 = idx >> 8, k = idx & 255, s2 = k & 127, part = k >> 7, ix = ((s2 * k2) & 127) * 64;
        F2[k2 * F2_LD + k] = (bf16)f2bf((part ? SIN[ix] : COS[ix]) * (1.0f / 1024.0f)); }
    __syncthreads();
    const int r32 = C.lane & 31, h = C.lane >> 5;
    for (int wu = C.gw; wu < BATCH * 64 * (FW / 32); wu += C.NGW) {
        const int ch0 = (wu & 15) * 32, k1 = (wu >> 4) & 63, b = wu >> 10;
        const bf16* yp = YP + ((size_t)((ch0 + r32) * 4 + b) * 64 + k1) * 256 + 8 * h;
        f32x16 acc[4];
#pragma unroll
        for (int mb = 0; mb < 4; ++mb)
#pragma unroll
            for (int i = 0; i < 16; ++i) acc[mb][i] = 0.f;
#pragma unroll 1
        for (int kh = 0; kh < 2; ++kh) {
            bf16x8 bfr[8];
#pragma unroll
            for (int ks = 0; ks < 8; ++ks) bfr[ks] = *(const bf16x8*)(yp + 128 * kh + 16 * ks);
#pragma unroll
            for (int ks = 0; ks < 8; ++ks)
#pragma unroll
                for (int mb = 0; mb < 4; ++mb) { const bf16x8 af = *(const LAS bf16x8*)(F2 + (mb * 32 + r32) * F2_LD + 128 * kh + 16 * ks + 8 * h); acc[mb] = __builtin_amdgcn_mfma_f32_32x32x16_bf16(af, bfr[ks], acc[mb], 0, 0, 0); }
        }
#pragma unroll
        for (int mb = 0; mb < 4; ++mb)
#pragma unroll
            for (int i = 0; i < 16; ++i) { const int k2 = mb * 32 + (i & 3) + 8 * (i >> 2) + 4 * h; FOUR[(size_t)(b * SEQ + k1 + 64 * k2) * FW + ch0 + r32] = (bf16)f2bf(acc[mb][i]); }
    }
    __syncthreads();
}

struct Args { const float* in[19]; float* out; unsigned char* ws; int ph_lo, ph_hi, li, pad; };
__global__ void __launch_bounds__(NWAVES * 64, 2) mk_fwd(Args args) {
    extern __shared__ __attribute__((aligned(16))) unsigned char lds_raw[];
    const int bx = blockIdx.x;
#define MKCTX() Ctx C; { int t_ = threadIdx.x; asm volatile("" : "+v"(t_)); C.lds = (LAS unsigned char*)lds_raw; C.tid = t_; C.lane = t_ & 63; C.wave = __builtin_amdgcn_readfirstlane(t_ >> 6); \
        C.G = gridDim.x; const int vcu_ = (C.G % 8 == 0) ? (bx % 8) * (C.G / 8) + bx / 8 : bx; C.gw = vcu_ * NWAVES + C.wave; C.NGW = C.G * NWAVES; }
    LAS unsigned char* const ldsb = (LAS unsigned char*)lds_raw; const int G_ = gridDim.x;
    volatile LAS unsigned* MISC = (volatile LAS unsigned*)(ldsb + MISC_OFF);
    unsigned char* ws = args.ws;
    unsigned* ctl = (unsigned*)(ws + WS_CTL);
    for (int u = threadIdx.x; u < (LDS_BYTES - LDSCTL_OFF) / 4; u += NWAVES * 64) ((LAS unsigned*)(ldsb + LDSCTL_OFF))[u] = 0u;
    __syncthreads();
    XcdBarrier bar; bar.bar = ctl + CW_BAR; bar.x = 0; bar.st = nullptr;
    if (N_LAUNCHES == 1) bar = xcd_barrier_post(ctl + CW_BAR, MISC + 8);
    Inputs I; { const float* const* p = args.in; I.x = p[0]; I.ln1g = p[1]; I.ln1b = p[2]; I.w1g = p[3]; I.w1u = p[4]; I.w1d = p[5]; I.win = p[6]; I.bin = p[7]; I.relb = p[8]; I.wpa = p[9]; I.wpf = p[10]; I.wout = p[11];
        I.ln2g = p[12]; I.ln2b = p[13]; I.w2g = p[14]; I.w2u = p[15]; I.w2d = p[16]; I.ln3g = p[17]; I.ln3b = p[18]; }
    float* OUT = args.out;
#define W1A ((bf16*)(ws + WS_W1A))
#define W1D ((bf16*)(ws + WS_W1D))
#define W2A ((bf16*)(ws + WS_W2A))
#define W2D ((bf16*)(ws + WS_W2D))
#define WIN ((bf16*)(ws + WS_WIN))
#define WSW ((bf16*)(ws + WS_WSW))
#define WPA ((bf16*)(ws + WS_WPA))
#define WOUT ((bf16*)(ws + WS_WOUT))
#define BIASN ((float*)(ws + WS_TAB + TAB_BIASN))
#define BIASW ((float*)(ws + WS_TAB + TAB_BIASW))
#define TBL ((float*)(ws + WS_TAB + TAB_TBL))
#define COS ((float*)(ws + WS_TAB + TAB_COS))
#define SIN ((float*)(ws + WS_TAB + TAB_SIN))
#define LSE ((float*)(ws + WS_TAB + TAB_LSE))
#define XB ((bf16*)(ws + WS_XB))
#define ACT ((bf16*)(ws + WS_ACT))
#define QB ((bf16*)(ws + WS_QB))
#define KB ((bf16*)(ws + WS_KB))
#define VT ((bf16*)(ws + WS_VT))
#define ATT ((bf16*)(ws + WS_ATT))
#define FOUR ((bf16*)(ws + WS_FOUR))
#define MRG ((bf16*)(ws + WS_MRG))
#define YP ((bf16*)(ws + WS_YP))
#define Z1 ((bf16*)(ws + WS_Z1))
#define GATES ((bf16*)OUT)
    LAS unsigned char* ring = ldsb + RING_OFF;

    const int lo = args.ph_lo, hi = args.ph_hi;
#define IN(k) (lo <= (k) && (k) < hi)
#define DUP(k) for (int rep_ = 0; rep_ < (((MK_DUP >> (k)) & 1) ? 2 : 1); ++rep_)
#define SEAM(k) do { if (IN(k) && IN((k) + 1)) xcd_barrier(bar); } while (0)
    if (IN(0)) DUP(0) { MKCTX(); p0_prologue(C, I, ws); VM_WAIT(); __syncthreads(); } SEAM(0);
    if (IN(1)) DUP(1) { SchedStd S{XB, W1A, D, D, T / 256, NUP / 256, G_, bx}; EpiSwiGLU E{ACT}; pg8::gemm_phase(ring, D, S, E); } SEAM(1);
    if (IN(2)) DUP(2) { SchedStd S{ACT, W1D, FFP, FFP, T / 256, D / 256, G_, bx}; EpiDown E{I.x, OUT}; pg8::gemm_phase(ring, FFP, S, E); } SEAM(2);
    if (IN(3)) DUP(3) { MKCTX(); ln_pass(C, OUT, nullptr, XB, I.ln1g, I.ln1b); } SEAM(3);
    if (IN(4)) { DUP(4) { SchedStd S{XB, WIN, D, D, T / 256, NIN / 256, G_, bx}; EpiInproj E{QB, KB, GATES, BIASN}; pg8::gemm_phase(ring, D, S, E); }
                 DUP(14) { SchedSw S{WSW, XB, G_, bx}; EpiSw E{VT, Z1, BIASW}; pg8::gemm_phase(ring, D, S, E); } } SEAM(4);
    if (IN(5)) { MKCTX(); if ((MK_DUP >> 5) & 1) attn_mfma(C, QB, KB, VT, LSE, TBL, args.pad == 0); attn_mfma(C, QB, KB, VT, LSE, TBL, false); } SEAM(5);
    if (IN(6)) DUP(6) { MKCTX(); combine_vec(C, QB, LSE, ATT); fft1_mfma(C, Z1, YP, COS, SIN); } SEAM(6);
    if (IN(7)) DUP(7) { MKCTX(); fft2_mfma(C, YP, FOUR, COS, SIN); } SEAM(7);
    if (IN(8)) DUP(8) { SchedProj S{ATT, WPA, G_, bx}; EpiProj E{GATES, MRG}; pg8::gemm_phase(ring, FW, S, E); } SEAM(8);
    if (IN(9)) DUP(9) { SchedStd S{MRG, WOUT, D, D, T / 256, D / 256, G_, bx}; EpiWout E{XB, OUT}; pg8::gemm_phase(ring, D, S, E); } SEAM(9);
    if (IN(10)) DUP(10) { MKCTX(); ln_pass(C, OUT, OUT, XB, I.ln2g, I.ln2b); } SEAM(10);
    if (IN(11)) DUP(11) { SchedStd S{XB, W2A, D, D, T / 256, NUP / 256, G_, bx}; EpiSwiGLU E{ACT}; pg8::gemm_phase(ring, D, S, E); } SEAM(11);
    if (IN(12)) DUP(12) { SchedStd S{ACT, W2D, FFP, FFP, T / 256, D / 256, G_, bx}; EpiDown E{OUT, OUT}; pg8::gemm_phase(ring, FFP, S, E); } SEAM(12);
    if (IN(13)) DUP(13) { MKCTX(); ln_pass(C, OUT, OUT, nullptr, I.ln3g, I.ln3b); }
#undef IN
#undef SEAM
}

extern "C" void kernel_launch(void* const* d_in, const int* in_sizes, int n_in, void* d_out, int out_size, void* d_ws, size_t ws_size, hipStream_t stream) {
    static int grid = 0;
    if (grid == 0) {
        if (n_in != 19 || out_size != T * D || ws_size < WS_END) { fprintf(stderr, "kernel_launch: unexpected shapes (n_in %d, out %d, ws %zu); nothing launched\n", n_in, out_size, ws_size); grid = -1; return; }
        int dev = 0, cus = 0, per_cu = 0;
        if (hipGetDevice(&dev) != hipSuccess || hipDeviceGetAttribute(&cus, hipDeviceAttributeMultiprocessorCount, dev) != hipSuccess) { grid = -1; return; }
        if (hipFuncSetAttribute((const void*)mk_fwd, hipFuncAttributeMaxDynamicSharedMemorySize, LDS_BYTES) != hipSuccess) { fprintf(stderr, "kernel_launch: hipFuncSetAttribute failed\n"); grid = -1; return; }
        if (hipOccupancyMaxActiveBlocksPerMultiprocessor(&per_cu, (const void*)mk_fwd, NWAVES * 64, LDS_BYTES) != hipSuccess || per_cu < 1) fprintf(stderr, "kernel_launch: occupancy query reports %d\n", per_cu);
        (void)hipGetLastError();
        grid = cus;
    }
    if (grid < 0) return;
    if (hipMemsetAsync((char*)d_ws + WS_CTL, 0, CTL_ZERO_BYTES, stream) != hipSuccess) return;
    Args a{};
    for (int i = 0; i < 19; ++i) a.in[i] = (const float*)d_in[i];
    a.out = (float*)d_out; a.ws = (unsigned char*)d_ws;
    if (N_LAUNCHES == 1) { a.ph_lo = 0; a.ph_hi = N_PHASES; a.li = 0; hipLaunchKernelGGL(mk_fwd, dim3(grid), dim3(NWAVES * 64), LDS_BYTES, stream, a); }
    else for (int li = 0; li < N_PHASES; ++li) { a.ph_lo = li; a.ph_hi = li + 1; a.li = li; hipLaunchKernelGGL(mk_fwd, dim3(grid), dim3(NWAVES * 64), LDS_BYTES, stream, a); }
}
```
